# Optimizing an MI355X kernel written in HIP

```python
import math
import jax, jax.numpy as jnp
from jax import lax
import numpy as np

D_MODEL = 1024
BATCH = 16
SEQ = 2048
DEPTH = 2

CHUNK = 64
PAST_CHUNKS = 8
BAND = (PAST_CHUNKS + 1) * CHUNK
PAD = PAST_CHUNKS * CHUNK
N_LAYERS_A = DEPTH // 2
N_LAYERS_B = DEPTH - N_LAYERS_A
HEAD_DIM = 64
A_HEADS = D_MODEL // HEAD_DIM
A_WIDTH = A_HEADS * HEAD_DIM
MAX_REL = 128
B_HEADS = D_MODEL // (2 * HEAD_DIM)
B_WIDTH = B_HEADS * 2 * HEAD_DIM
ROT_DIM = HEAD_DIM // 4
ROPE_THETA = 500000.0
Q_BLOCK = 128
RMS_EPS = 1e-6
NEG_INF = -1e30

kernel_name = "yoco_chunked_relpos_diff_attention_trunk"


def rmsnorm(t, g):
    tf = t.astype(jnp.float32)
    y = tf * lax.rsqrt(jnp.mean(tf * tf, axis=-1, keepdims=True) + RMS_EPS)
    return (y * g.astype(jnp.float32)).astype(t.dtype)


def partial_rope(t, positions):
    half = ROT_DIM // 2
    inv_freq = jnp.power(jnp.float32(ROPE_THETA), -jnp.arange(half, dtype=jnp.float32) * 2.0 / ROT_DIM)
    ang = positions.astype(jnp.float32)[..., None] * inv_freq
    ang = ang.reshape(ang.shape[:2] + (1,) * (t.ndim - 3) + (half,))
    cos = jnp.cos(ang).astype(t.dtype)
    sin = jnp.sin(ang).astype(t.dtype)
    t1 = t[..., :half]
    t2 = t[..., half:ROT_DIM]
    return jnp.concatenate([t1 * cos - t2 * sin, t2 * cos + t1 * sin, t[..., ROT_DIM:]], axis=-1)


def chunk_band_attention(q, k, v, positions, rel_bias):
    B, S, H, dh = q.shape
    n_chunks = S // CHUNK
    scale = 1.0 / math.sqrt(dh)
    qt = q.transpose(0, 2, 1, 3).reshape(B, H, n_chunks, CHUNK, dh).transpose(2, 0, 1, 3, 4)
    kp = jnp.pad(k.transpose(0, 2, 1, 3), ((0, 0), (0, 0), (PAD, 0), (0, 0)))
    vp = jnp.pad(v.transpose(0, 2, 1, 3), ((0, 0), (0, 0), (PAD, 0), (0, 0)))
    posp = jnp.pad(positions, ((0, 0), (PAD, 0)))

    def one_chunk(args):
        qc, c = args
        start = c * CHUNK
        kb = lax.dynamic_slice_in_dim(kp, start, BAND, axis=2)
        vb = lax.dynamic_slice_in_dim(vp, start, BAND, axis=2)
        kpos = lax.dynamic_slice_in_dim(posp, start, BAND, axis=1)
        qpos = lax.dynamic_slice_in_dim(positions, start, CHUNK, axis=1)
        valid = (start + jnp.arange(BAND)) >= PAD
        rel = jnp.clip(qpos[:, :, None] - kpos[:, None, :], -MAX_REL, MAX_REL) + MAX_REL
        bias = jnp.take(rel_bias, rel, axis=1).transpose(1, 0, 2, 3)
        s = jnp.einsum('bhqd,bhkd->bhqk', qc, kb).astype(jnp.float32) * scale
        s = s + bias.astype(jnp.float32)
        s = jnp.where(valid[None, None, None, :], s, NEG_INF)
        p = jax.nn.softmax(s, axis=-1)
        return jnp.einsum('bhqk,bhkd->bhqd', p.astype(vb.dtype), vb)

    out = lax.map(one_chunk, (qt, jnp.arange(n_chunks)))
    return out.transpose(1, 0, 3, 2, 4).reshape(B, S, H * dh)


def diff_attention(q, k, v, lam):
    B, S, H, _, dh = q.shape
    n_blocks = S // Q_BLOCK
    scale = 1.0 / math.sqrt(dh)
    qb = q.transpose(0, 2, 3, 1, 4).reshape(B, H, 2, n_blocks, Q_BLOCK, dh).transpose(3, 0, 1, 2, 4, 5)
    kchunk = jnp.arange(S) // CHUNK

    def one_block(args):
        qblk, bi = args
        s = jnp.einsum('bhmqd,bhmkd->bhmqk', qblk, k).astype(jnp.float32) * scale
        qchunk = (bi * Q_BLOCK + jnp.arange(Q_BLOCK)) // CHUNK
        mask = kchunk[None, :] <= qchunk[:, None]
        s = jnp.where(mask[None, None, None], s, NEG_INF)
        p = jax.nn.softmax(s, axis=-1)
        a = p[:, :, 0] - lam * p[:, :, 1]
        return jnp.einsum('bhqk,bhkd->bhqd', a.astype(v.dtype), v)

    out = lax.map(one_block, (qb, jnp.arange(n_blocks)))
    return out.transpose(1, 0, 3, 2, 4).reshape(B, S, H, 2 * dh)


def setup_inputs(seed: int = 0) -> dict:
    key = jax.random.key(seed)
    ks = jax.random.split(key, 20)
    f32 = jnp.float32
    nrm = lambda k, shp, s: jax.random.normal(k, shp, f32) * s
    x = jax.random.normal(ks[0], (BATCH, SEQ, D_MODEL), f32)
    offset = jax.random.randint(ks[1], (BATCH, 1), 0, 64, dtype=jnp.int32) * CHUNK
    positions = (offset + jnp.arange(SEQ, dtype=jnp.int32)[None, :]).astype(jnp.int32)
    return {
        "x": x,
        "positions": positions,
        "a_norm_pre": 1.0 + nrm(ks[2], (N_LAYERS_A, D_MODEL), 0.01),
        "a_w_in": nrm(ks[3], (N_LAYERS_A, D_MODEL, 4 * A_WIDTH), D_MODEL ** -0.5),
        "a_rel_bias": nrm(ks[4], (N_LAYERS_A, A_HEADS, 2 * MAX_REL + 1), 0.5),
        "a_w_out": nrm(ks[5], (N_LAYERS_A, A_WIDTH, D_MODEL), A_WIDTH ** -0.5),
        "a_norm_post": 1.0 + nrm(ks[6], (N_LAYERS_A, D_MODEL), 0.01),
        "kv_norm": 1.0 + nrm(ks[7], (D_MODEL,), 0.01),
        "kv_w": nrm(ks[8], (D_MODEL, 2 * B_WIDTH), D_MODEL ** -0.5),
        "b_norm_pre": 1.0 + nrm(ks[9], (N_LAYERS_B, D_MODEL), 0.01),
        "b_w_in": nrm(ks[10], (N_LAYERS_B, D_MODEL, 2 * B_WIDTH), D_MODEL ** -0.5),
        "b_lambda_q1": nrm(ks[11], (N_LAYERS_B, HEAD_DIM), 0.1),
        "b_lambda_k1": nrm(ks[12], (N_LAYERS_B, HEAD_DIM), 0.1),
        "b_lambda_q2": nrm(ks[13], (N_LAYERS_B, HEAD_DIM), 0.1),
        "b_lambda_k2": nrm(ks[14], (N_LAYERS_B, HEAD_DIM), 0.1),
        "b_subln": 1.0 + nrm(ks[15], (N_LAYERS_B, 2 * HEAD_DIM), 0.01),
        "b_w_out": nrm(ks[16], (N_LAYERS_B, B_WIDTH, D_MODEL), B_WIDTH ** -0.5),
        "b_norm_post": 1.0 + nrm(ks[17], (N_LAYERS_B, D_MODEL), 0.01),
    }


def reference(x, positions, a_norm_pre, a_w_in, a_rel_bias, a_w_out, a_norm_post,
              kv_norm, kv_w, b_norm_pre, b_w_in, b_lambda_q1, b_lambda_k1,
              b_lambda_q2, b_lambda_k2, b_subln, b_w_out, b_norm_post):
    B, S, _ = x.shape
    h = x
    k_sh = None
    v_sh = None
    for layer in range(DEPTH):
        if layer < N_LAYERS_A:
            i = layer
            u = rmsnorm(h, a_norm_pre[i])
            proj = u @ a_w_in[i]
            q, k, v, g = jnp.split(proj, 4, axis=-1)
            q = q.reshape(B, S, A_HEADS, HEAD_DIM)
            k = k.reshape(B, S, A_HEADS, HEAD_DIM)
            v = v.reshape(B, S, A_HEADS, HEAD_DIM)
            o = chunk_band_attention(q, k, v, positions, a_rel_bias[i])
            y = (o * jax.nn.silu(g)) @ a_w_out[i]
            h = h + rmsnorm(y, a_norm_post[i])
            if layer == N_LAYERS_A - 1:
                kv = rmsnorm(h, kv_norm) @ kv_w
                ks_, vs_ = jnp.split(kv, 2, axis=-1)
                ks_ = partial_rope(ks_.reshape(B, S, B_HEADS, 2, HEAD_DIM), positions)
                k_sh = ks_.transpose(0, 2, 3, 1, 4)
                v_sh = vs_.reshape(B, S, B_HEADS, 2 * HEAD_DIM).transpose(0, 2, 1, 3)
        else:
            j = layer - N_LAYERS_A
            lam_init = 0.8 - 0.6 * math.exp(-0.3 * layer)
            lam = (jnp.exp(jnp.sum(b_lambda_q1[j].astype(jnp.float32) * b_lambda_k1[j].astype(jnp.float32)))
                   - jnp.exp(jnp.sum(b_lambda_q2[j].astype(jnp.float32) * b_lambda_k2[j].astype(jnp.float32)))
                   + lam_init)
            u = rmsnorm(h, b_norm_pre[j])
            proj = u @ b_w_in[j]
            q, g = jnp.split(proj, 2, axis=-1)
            q = partial_rope(q.reshape(B, S, B_HEADS, 2, HEAD_DIM), positions)
            o = diff_attention(q, k_sh, v_sh, lam)
            o = rmsnorm(o, b_subln[j]) * (1.0 - lam_init)
            y = (o.reshape(B, S, B_WIDTH) * jax.nn.silu(g)) @ b_w_out[j]
            h = h + rmsnorm(y, b_norm_post[j])
    return h
```

```cpp
#include <hip/hip_runtime.h>
#include <cstdint>
#include <cstdio>

typedef unsigned short bf16_t;
constexpr int BATCH = 16, SEQ = 2048, DM = 1024, T = BATCH * SEQ;
constexpr int CHUNK = 64, PAST = 8, BAND = 576, MAXREL = 128, NREL = 257;
constexpr int AH = 16, HD = 64, BH = 8;
constexpr float EPS = 1e-6f;
constexpr float LAM_INIT = 0.35550906759096924f;

__device__ __forceinline__ float bf2f(bf16_t v) { return __uint_as_float((unsigned)v << 16); }
__device__ __forceinline__ bf16_t f2bf(float f) { unsigned u = __float_as_uint(f); return (bf16_t)((u + 0x7fffu + ((u >> 16) & 1u)) >> 16); }
__device__ __forceinline__ float wave_sum(float v) {
#pragma unroll
    for (int o = 1; o < 64; o <<= 1) v += __shfl_xor(v, o);
    return v;
}

__global__ void prep_w(const float* W, const float* g, int K, int N, bf16_t* Wt, int row_off) {
    int n = blockIdx.x * 64 + (threadIdx.x & 63);
    int k0 = blockIdx.y * 64;
    for (int kk = threadIdx.x >> 6; kk < 64; kk += 4) {
        int k = k0 + kk;
        float gv = g ? g[k] : 1.f;
        Wt[(size_t)(row_off + n) * K + k] = f2bf(W[(size_t)k * N + n] * gv);
    }
}
__global__ void rms_rows(const float* x, bf16_t* xn) {
    int row = blockIdx.x * 4 + (threadIdx.x >> 6), lane = threadIdx.x & 63;
    const float* xr = x + (size_t)row * DM;
    float v[16]; float s = 0.f;
#pragma unroll
    for (int j = 0; j < 16; ++j) { v[j] = xr[lane + 64 * j]; s += v[j] * v[j]; }
    s = wave_sum(s);
    float r = rsqrtf(s * (1.f / DM) + EPS);
#pragma unroll
    for (int j = 0; j < 16; ++j) xn[(size_t)row * DM + lane + 64 * j] = f2bf(v[j] * r);
}
__global__ void rope_table(const int* pos, float* cs) {
    int idx = blockIdx.x * 256 + threadIdx.x;
    if (idx >= T * 8) return;
    int t = idx >> 3, i = idx & 7;
    float inv = powf(500000.0f, -(float)i * 2.0f / 16.0f);
    float ang = (float)pos[t] * inv;
    cs[t * 16 + i] = cosf(ang);
    cs[t * 16 + 8 + i] = sinf(ang);
}

template <int MODE>
__global__ void __launch_bounds__(256) gemm_naive(const bf16_t* A, const bf16_t* Bt, int M, int N, int K, bf16_t* Cb, size_t split_stride, float* Cf) {
    __shared__ float As[32][65];
    __shared__ float Bs[32][65];
    int tx = threadIdx.x & 15, ty = threadIdx.x >> 4;
    int m0 = blockIdx.y * 64, n0 = blockIdx.x * 64;
    float acc[4][4] = {};
    int lr = threadIdx.x >> 2, lc = (threadIdx.x & 3) * 8;
    for (int k0 = 0; k0 < K; k0 += 32) {
        uint4 av = *(const uint4*)(A + (size_t)(m0 + lr) * K + k0 + lc);
        uint4 bv = *(const uint4*)(Bt + (size_t)(n0 + lr) * K + k0 + lc);
        unsigned aw[4] = {av.x, av.y, av.z, av.w}, bw[4] = {bv.x, bv.y, bv.z, bv.w};
#pragma unroll
        for (int j = 0; j < 4; ++j) {
            As[lc + 2 * j][lr] = __uint_as_float(aw[j] << 16); As[lc + 2 * j + 1][lr] = __uint_as_float(aw[j] & 0xffff0000u);
            Bs[lc + 2 * j][lr] = __uint_as_float(bw[j] << 16); Bs[lc + 2 * j + 1][lr] = __uint_as_float(bw[j] & 0xffff0000u);
        }
        __syncthreads();
#pragma unroll 8
        for (int k = 0; k < 32; ++k) {
            float a[4], b[4];
#pragma unroll
            for (int i = 0; i < 4; ++i) { a[i] = As[k][ty * 4 + i]; b[i] = Bs[k][tx * 4 + i]; }
#pragma unroll
            for (int i = 0; i < 4; ++i)
#pragma unroll
                for (int j = 0; j < 4; ++j) acc[i][j] += a[i] * b[j];
        }
        __syncthreads();
    }
#pragma unroll
    for (int i = 0; i < 4; ++i) {
        int row = m0 + ty * 4 + i;
#pragma unroll
        for (int j = 0; j < 4; ++j) {
            int col = n0 + tx * 4 + j;
            if (MODE == 0) { int t = col >> 10; Cb[(size_t)t * split_stride + (size_t)row * DM + (col & 1023)] = f2bf(acc[i][j]); }
            else Cf[(size_t)row * N + col] = acc[i][j];
        }
    }
}

__global__ void __launch_bounds__(64) attn_a_naive(const bf16_t* Q, const bf16_t* Kb, const bf16_t* Vb, const bf16_t* G, const int* pos, const float* relb, bf16_t* OG) {
    int gid = blockIdx.x * 64 + threadIdx.x;
    int q = gid & (SEQ - 1), h = (gid >> 11) & 15, b = gid >> 15;
    int c = q >> 6;
    size_t trow = (size_t)b * SEQ + q;
    float qv[64];
#pragma unroll
    for (int d = 0; d < 64; ++d) qv[d] = bf2f(Q[trow * DM + h * 64 + d]);
    int qpos = pos[trow];
    const float* rb = relb + h * NREL;
    int kstart = (c - PAST) * CHUNK; if (kstart < 0) kstart = 0;
    int kend = (c + 1) * CHUNK;
    float m = -1e30f, l = 0.f;
    for (int k = kstart; k < kend; ++k) {
        size_t krow = (size_t)b * SEQ + k;
        const uint4* kp = (const uint4*)(Kb + krow * DM + h * 64);
        float s = 0.f;
#pragma unroll
        for (int j = 0; j < 8; ++j) { uint4 w = kp[j]; unsigned ww[4] = {w.x, w.y, w.z, w.w};
#pragma unroll
            for (int e = 0; e < 4; ++e) { s += qv[j * 8 + 2 * e] * __uint_as_float(ww[e] << 16) + qv[j * 8 + 2 * e + 1] * __uint_as_float(ww[e] & 0xffff0000u); } }
        int rel = qpos - pos[krow]; rel = rel < -MAXREL ? -MAXREL : (rel > MAXREL ? MAXREL : rel);
        s = s * 0.125f + rb[rel + MAXREL];
        float mn = fmaxf(m, s);
        l = l * __expf(m - mn) + __expf(s - mn); m = mn;
    }
    float o[64];
#pragma unroll
    for (int d = 0; d < 64; ++d) o[d] = 0.f;
    float il = 1.f / l;
    for (int k = kstart; k < kend; ++k) {
        size_t krow = (size_t)b * SEQ + k;
        const uint4* kp = (const uint4*)(Kb + krow * DM + h * 64);
        float s = 0.f;
#pragma unroll
        for (int j = 0; j < 8; ++j) { uint4 w = kp[j]; unsigned ww[4] = {w.x, w.y, w.z, w.w};
#pragma unroll
            for (int e = 0; e < 4; ++e) { s += qv[j * 8 + 2 * e] * __uint_as_float(ww[e] << 16) + qv[j * 8 + 2 * e + 1] * __uint_as_float(ww[e] & 0xffff0000u); } }
        int rel = qpos - pos[krow]; rel = rel < -MAXREL ? -MAXREL : (rel > MAXREL ? MAXREL : rel);
        s = s * 0.125f + rb[rel + MAXREL];
        float p = __expf(s - m) * il;
        const uint4* vp = (const uint4*)(Vb + krow * DM + h * 64);
#pragma unroll
        for (int j = 0; j < 8; ++j) { uint4 w = vp[j]; unsigned ww[4] = {w.x, w.y, w.z, w.w};
#pragma unroll
            for (int e = 0; e < 4; ++e) { o[j * 8 + 2 * e] += p * __uint_as_float(ww[e] << 16); o[j * 8 + 2 * e + 1] += p * __uint_as_float(ww[e] & 0xffff0000u); } }
    }
#pragma unroll
    for (int d = 0; d < 64; ++d) {
        float g = bf2f(G[trow * DM + h * 64 + d]);
        float sg = g / (1.f + __expf(-g));
        OG[trow * DM + h * 64 + d] = f2bf(o[d] * sg);
    }
}

__global__ void resnorm_rows(const float* xin, const float* y, const float* g, float* out, bf16_t* hn) {
    int row = blockIdx.x * 4 + (threadIdx.x >> 6), lane = threadIdx.x & 63;
    float v[16]; float s = 0.f;
#pragma unroll
    for (int j = 0; j < 16; ++j) { v[j] = y[(size_t)row * DM + lane + 64 * j]; s += v[j] * v[j]; }
    s = wave_sum(s);
    float r = rsqrtf(s * (1.f / DM) + EPS);
    float s2 = 0.f;
#pragma unroll
    for (int j = 0; j < 16; ++j) { int c = lane + 64 * j; v[j] = xin[(size_t)row * DM + c] + v[j] * r * g[c]; s2 += v[j] * v[j]; }
#pragma unroll
    for (int j = 0; j < 16; ++j) out[(size_t)row * DM + lane + 64 * j] = v[j];
    if (hn) {
        s2 = wave_sum(s2);
        float r2 = rsqrtf(s2 * (1.f / DM) + EPS);
#pragma unroll
        for (int j = 0; j < 16; ++j) hn[(size_t)row * DM + lane + 64 * j] = f2bf(v[j] * r2);
    }
}

__global__ void rope_inplace(bf16_t* buf, const float* cs) {
    int idx = blockIdx.x * 256 + threadIdx.x;
    int i = idx & 7, grp = (idx >> 3) & 15, t = idx >> 7;
    if (t >= T) return;
    float c = cs[t * 16 + i], s = cs[t * 16 + 8 + i];
    bf16_t* p = buf + (size_t)t * DM + grp * 64;
    float t1 = bf2f(p[i]), t2 = bf2f(p[8 + i]);
    p[i] = f2bf(t1 * c - t2 * s);
    p[8 + i] = f2bf(t2 * c + t1 * s);
}

__global__ void __launch_bounds__(64) attn_b_naive(const bf16_t* Q, const bf16_t* Kb, const bf16_t* Vb, const bf16_t* G,
                                                   const float* lq1, const float* lk1, const float* lq2, const float* lk2, const float* subln, bf16_t* OG) {
    int gid = blockIdx.x * 64 + threadIdx.x;
    int m = gid & 1, rowid = gid >> 1;
    int q = rowid & (SEQ - 1), h = (rowid >> 11) & 7, b = rowid >> 14;
    float d1 = 0.f, d2 = 0.f;
    for (int i = 0; i < 64; ++i) { d1 += lq1[i] * lk1[i]; d2 += lq2[i] * lk2[i]; }
    float lam = __expf(d1) - __expf(d2) + LAM_INIT;
    size_t trow = (size_t)b * SEQ + q;
    float qv[64];
#pragma unroll
    for (int d = 0; d < 64; ++d) qv[d] = bf2f(Q[trow * DM + h * 128 + m * 64 + d]);
    int kend = ((q >> 6) + 1) * CHUNK;
    float mx = -1e30f, l = 0.f;
    for (int k = 0; k < kend; ++k) {
        size_t krow = (size_t)b * SEQ + k;
        const uint4* kp = (const uint4*)(Kb + krow * DM + h * 128 + m * 64);
        float s = 0.f;
#pragma unroll
        for (int j = 0; j < 8; ++j) { uint4 w = kp[j]; unsigned ww[4] = {w.x, w.y, w.z, w.w};
#pragma unroll
            for (int e = 0; e < 4; ++e) { s += qv[j * 8 + 2 * e] * __uint_as_float(ww[e] << 16) + qv[j * 8 + 2 * e + 1] * __uint_as_float(ww[e] & 0xffff0000u); } }
        s *= 0.125f;
        float mn = fmaxf(mx, s);
        l = l * __expf(mx - mn) + __expf(s - mn); mx = mn;
    }
    float o[64];
#pragma unroll
    for (int d = 0; d < 64; ++d) o[d] = 0.f;
    float il = 1.f / l;
    for (int k = 0; k < kend; ++k) {
        size_t krow = (size_t)b * SEQ + k;
        const uint4* kp = (const uint4*)(Kb + krow * DM + h * 128 + m * 64);
        float s = 0.f;
#pragma unroll
        for (int j = 0; j < 8; ++j) { uint4 w = kp[j]; unsigned ww[4] = {w.x, w.y, w.z, w.w};
#pragma unroll
            for (int e = 0; e < 4; ++e) { s += qv[j * 8 + 2 * e] * __uint_as_float(ww[e] << 16) + qv[j * 8 + 2 * e + 1] * __uint_as_float(ww[e] & 0xffff0000u); } }
        float p = __expf(s * 0.125f - mx) * il;
        float po = __shfl_xor(p, 1);
        float p0 = m ? po : p, p1 = m ? p : po;
        float a = p0 - lam * p1;
        const uint4* vp = (const uint4*)(Vb + krow * DM + h * 128 + m * 64);
#pragma unroll
        for (int j = 0; j < 8; ++j) { uint4 w = vp[j]; unsigned ww[4] = {w.x, w.y, w.z, w.w};
#pragma unroll
            for (int e = 0; e < 4; ++e) { o[j * 8 + 2 * e] += a * __uint_as_float(ww[e] << 16); o[j * 8 + 2 * e + 1] += a * __uint_as_float(ww[e] & 0xffff0000u); } }
    }
    float ss = 0.f;
#pragma unroll
    for (int d = 0; d < 64; ++d) ss += o[d] * o[d];
    ss += __shfl_xor(ss, 1);
    float r = rsqrtf(ss * (1.f / 128.f) + EPS) * (1.f - LAM_INIT);
#pragma unroll
    for (int d = 0; d < 64; ++d) {
        int c = h * 128 + m * 64 + d;
        float g = bf2f(G[trow * DM + c]);
        float sg = g / (1.f + __expf(-g));
        OG[trow * DM + c] = f2bf(o[d] * r * subln[m * 64 + d] * sg);
    }
}

extern "C" void kernel_launch(void* const* d_in, const int* in_sizes, int n_in, void* d_out, int out_size, void* d_ws, size_t ws_size, hipStream_t stream) {
    const float* x = (const float*)d_in[0]; const int* pos = (const int*)d_in[1];
    const float* a_norm_pre = (const float*)d_in[2]; const float* a_w_in = (const float*)d_in[3]; const float* a_rel_bias = (const float*)d_in[4];
    const float* a_w_out = (const float*)d_in[5]; const float* a_norm_post = (const float*)d_in[6]; const float* kv_norm = (const float*)d_in[7];
    const float* kv_w = (const float*)d_in[8]; const float* b_norm_pre = (const float*)d_in[9]; const float* b_w_in = (const float*)d_in[10];
    const float* lq1 = (const float*)d_in[11]; const float* lk1 = (const float*)d_in[12]; const float* lq2 = (const float*)d_in[13]; const float* lk2 = (const float*)d_in[14];
    const float* b_subln = (const float*)d_in[15]; const float* b_w_out = (const float*)d_in[16]; const float* b_norm_post = (const float*)d_in[17];
    float* out = (float*)d_out;
    unsigned char* ws = (unsigned char*)d_ws;
    const size_t MiB = 1u << 20;
    bf16_t* Wt_in_a = (bf16_t*)(ws + 0 * MiB);
    bf16_t* Wt_out_a = (bf16_t*)(ws + 8 * MiB);
    bf16_t* Wt_cat = (bf16_t*)(ws + 10 * MiB);
    bf16_t* Wt_out_b = (bf16_t*)(ws + 18 * MiB);
    float* cs = (float*)(ws + 20 * MiB);
    bf16_t* XN = (bf16_t*)(ws + 32 * MiB);
    bf16_t* QKVG = (bf16_t*)(ws + 96 * MiB);
    const size_t SPL = (size_t)T * DM;
    float* Y = (float*)(ws + 352 * MiB);
    bf16_t *Qa = QKVG, *Ka = QKVG + SPL, *Va = QKVG + 2 * SPL, *Ga = QKVG + 3 * SPL;

    prep_w<<<dim3(4096 / 64, 1024 / 64), 256, 0, stream>>>(a_w_in, a_norm_pre, 1024, 4096, Wt_in_a, 0);
    prep_w<<<dim3(1024 / 64, 1024 / 64), 256, 0, stream>>>(a_w_out, nullptr, 1024, 1024, Wt_out_a, 0);
    prep_w<<<dim3(2048 / 64, 1024 / 64), 256, 0, stream>>>(kv_w, kv_norm, 1024, 2048, Wt_cat, 0);
    prep_w<<<dim3(2048 / 64, 1024 / 64), 256, 0, stream>>>(b_w_in, b_norm_pre, 1024, 2048, Wt_cat, 2048);
    prep_w<<<dim3(1024 / 64, 1024 / 64), 256, 0, stream>>>(b_w_out, nullptr, 1024, 1024, Wt_out_b, 0);
    rope_table<<<T * 8 / 256, 256, 0, stream>>>(pos, cs);
    rms_rows<<<T / 4, 256, 0, stream>>>(x, XN);
    gemm_naive<0><<<dim3(4096 / 64, T / 64), 256, 0, stream>>>(XN, Wt_in_a, T, 4096, 1024, QKVG, SPL, nullptr);
    attn_a_naive<<<T * AH / 64, 64, 0, stream>>>(Qa, Ka, Va, Ga, pos, a_rel_bias, Qa);
    gemm_naive<1><<<dim3(1024 / 64, T / 64), 256, 0, stream>>>(Qa, Wt_out_a, T, 1024, 1024, nullptr, 0, Y);
    resnorm_rows<<<T / 4, 256, 0, stream>>>(x, Y, a_norm_post, out, XN);
    gemm_naive<0><<<dim3(4096 / 64, T / 64), 256, 0, stream>>>(XN, Wt_cat, T, 4096, 1024, QKVG, SPL, nullptr);
    rope_inplace<<<T * 128 / 256, 256, 0, stream>>>(QKVG, cs);
    rope_inplace<<<T * 128 / 256, 256, 0, stream>>>(QKVG + 2 * SPL, cs);
    attn_b_naive<<<T * BH * 2 / 64, 64, 0, stream>>>(QKVG + 2 * SPL, QKVG, QKVG + SPL, QKVG + 3 * SPL, lq1, lk1, lq2, lk2, b_subln, QKVG + 2 * SPL);
    gemm_naive<1><<<dim3(1024 / 64, T / 64), 256, 0, stream>>>(QKVG + 2 * SPL, Wt_out_b, T, 1024, 1024, nullptr, 0, Y);
    resnorm_rows<<<T / 4, 256, 0, stream>>>(out, Y, b_norm_post, out, nullptr);
}
```

```cpp
#include <hip/hip_runtime.h>
#include <cstdint>
#include <cstdio>

#ifndef HYBRID
#define HYBRID 1
#endif

typedef unsigned short bf16_t;
constexpr int BATCH = 16, SEQ = 2048, DM = 1024, T = BATCH * SEQ;
constexpr int CHUNK = 64, PAST = 8, MAXREL = 128, NREL = 257;
constexpr float EPS = 1e-6f;
constexpr float LAM_INIT = 0.35550906759096924f;
constexpr float LOG2E = 1.4426950408889634f;
constexpr float C2 = 0.125f * LOG2E;

__device__ __forceinline__ float bf2f(bf16_t v) { return __uint_as_float((unsigned)v << 16); }
__device__ __forceinline__ bf16_t f2bf(float f) { unsigned u = __float_as_uint(f); return (bf16_t)((u + 0x7fffu + ((u >> 16) & 1u)) >> 16); }

#if HYBRID
__global__ void __launch_bounds__(64) attn_a_naive(const bf16_t* Q, const bf16_t* Kb, const bf16_t* Vb, const bf16_t* G, const int* pos, const float* relb, bf16_t* OG) {
    int gid = blockIdx.x * 64 + threadIdx.x;
    int q = gid & (SEQ - 1), h = (gid >> 11) & 15, b = gid >> 15;
    int c = q >> 6;
    size_t trow = (size_t)b * SEQ + q;
    float qv[64];
#pragma unroll
    for (int d = 0; d < 64; ++d) qv[d] = bf2f(Q[trow * DM + h * 64 + d]);
    int qpos = pos[trow];
    const float* rb = relb + h * NREL;
    int kstart = (c - PAST) * CHUNK; if (kstart < 0) kstart = 0;
    int kend = (c + 1) * CHUNK;
    float m = -1e30f, l = 0.f;
    for (int k = kstart; k < kend; ++k) {
        size_t krow = (size_t)b * SEQ + k;
        const uint4* kp = (const uint4*)(Kb + krow * DM + h * 64);
        float s = 0.f;
#pragma unroll
        for (int j = 0; j < 8; ++j) { uint4 w = kp[j]; unsigned ww[4] = {w.x, w.y, w.z, w.w};
#pragma unroll
            for (int e = 0; e < 4; ++e) { s += qv[j * 8 + 2 * e] * __uint_as_float(ww[e] << 16) + qv[j * 8 + 2 * e + 1] * __uint_as_float(ww[e] & 0xffff0000u); } }
        int rel = qpos - pos[krow]; rel = rel < -MAXREL ? -MAXREL : (rel > MAXREL ? MAXREL : rel);
        s = s + rb[rel + MAXREL] * LOG2E;
        float mn = fmaxf(m, s);
        l = l * exp2f(m - mn) + exp2f(s - mn); m = mn;
    }
    float o[64];
#pragma unroll
    for (int d = 0; d < 64; ++d) o[d] = 0.f;
    float il = 1.f / l;
    for (int k = kstart; k < kend; ++k) {
        size_t krow = (size_t)b * SEQ + k;
        const uint4* kp = (const uint4*)(Kb + krow * DM + h * 64);
        float s = 0.f;
#pragma unroll
        for (int j = 0; j < 8; ++j) { uint4 w = kp[j]; unsigned ww[4] = {w.x, w.y, w.z, w.w};
#pragma unroll
            for (int e = 0; e < 4; ++e) { s += qv[j * 8 + 2 * e] * __uint_as_float(ww[e] << 16) + qv[j * 8 + 2 * e + 1] * __uint_as_float(ww[e] & 0xffff0000u); } }
        int rel = qpos - pos[krow]; rel = rel < -MAXREL ? -MAXREL : (rel > MAXREL ? MAXREL : rel);
        s = s + rb[rel + MAXREL] * LOG2E;
        float p = exp2f(s - m) * il;
        const uint4* vp = (const uint4*)(Vb + krow * DM + h * 64);
#pragma unroll
        for (int j = 0; j < 8; ++j) { uint4 w = vp[j]; unsigned ww[4] = {w.x, w.y, w.z, w.w};
#pragma unroll
            for (int e = 0; e < 4; ++e) { o[j * 8 + 2 * e] += p * __uint_as_float(ww[e] << 16); o[j * 8 + 2 * e + 1] += p * __uint_as_float(ww[e] & 0xffff0000u); } }
    }
#pragma unroll
    for (int d = 0; d < 64; ++d) {
        float g = bf2f(G[trow * DM + h * 64 + d]);
        float sg = g / (1.f + __expf(-g));
        OG[trow * DM + h * 64 + d] = f2bf(o[d] * sg);
    }
}

__global__ void __launch_bounds__(64) attn_b_naive(const bf16_t* Q, const bf16_t* Kb, const bf16_t* Vb, const bf16_t* G,
                                                   const float* lq1, const float* lk1, const float* lq2, const float* lk2, const float* subln, bf16_t* OG) {
    int gid = blockIdx.x * 64 + threadIdx.x;
    int m = gid & 1, rowid = gid >> 1;
    int q = rowid & (SEQ - 1), h = (rowid >> 11) & 7, b = rowid >> 14;
    float d1 = 0.f, d2 = 0.f;
    for (int i = 0; i < 64; ++i) { d1 += lq1[i] * lk1[i]; d2 += lq2[i] * lk2[i]; }
    float lam = __expf(d1) - __expf(d2) + LAM_INIT;
    size_t trow = (size_t)b * SEQ + q;
    float qv[64];
#pragma unroll
    for (int d = 0; d < 64; ++d) qv[d] = bf2f(Q[trow * DM + h * 128 + m * 64 + d]);
    int kend = ((q >> 6) + 1) * CHUNK;
    float mx = -1e30f, l = 0.f;
    for (int k = 0; k < kend; ++k) {
        size_t krow = (size_t)b * SEQ + k;
        const uint4* kp = (const uint4*)(Kb + krow * DM + h * 128 + m * 64);
        float s = 0.f;
#pragma unroll
        for (int j = 0; j < 8; ++j) { uint4 w = kp[j]; unsigned ww[4] = {w.x, w.y, w.z, w.w};
#pragma unroll
            for (int e = 0; e < 4; ++e) { s += qv[j * 8 + 2 * e] * __uint_as_float(ww[e] << 16) + qv[j * 8 + 2 * e + 1] * __uint_as_float(ww[e] & 0xffff0000u); } }
        float mn = fmaxf(mx, s);
        l = l * exp2f(mx - mn) + exp2f(s - mn); mx = mn;
    }
    float o[64];
#pragma unroll
    for (int d = 0; d < 64; ++d) o[d] = 0.f;
    float il = 1.f / l;
    for (int k = 0; k < kend; ++k) {
        size_t krow = (size_t)b * SEQ + k;
        const uint4* kp = (const uint4*)(Kb + krow * DM + h * 128 + m * 64);
        float s = 0.f;
#pragma unroll
        for (int j = 0; j < 8; ++j) { uint4 w = kp[j]; unsigned ww[4] = {w.x, w.y, w.z, w.w};
#pragma unroll
            for (int e = 0; e < 4; ++e) { s += qv[j * 8 + 2 * e] * __uint_as_float(ww[e] << 16) + qv[j * 8 + 2 * e + 1] * __uint_as_float(ww[e] & 0xffff0000u); } }
        float p = exp2f(s - mx) * il;
        float po = __shfl_xor(p, 1);
        float p0 = m ? po : p, p1 = m ? p : po;
        float a = p0 - lam * p1;
        const uint4* vp = (const uint4*)(Vb + krow * DM + h * 128 + m * 64);
#pragma unroll
        for (int j = 0; j < 8; ++j) { uint4 w = vp[j]; unsigned ww[4] = {w.x, w.y, w.z, w.w};
#pragma unroll
            for (int e = 0; e < 4; ++e) { o[j * 8 + 2 * e] += a * __uint_as_float(ww[e] << 16); o[j * 8 + 2 * e + 1] += a * __uint_as_float(ww[e] & 0xffff0000u); } }
    }
    float ss = 0.f;
#pragma unroll
    for (int d = 0; d < 64; ++d) ss += o[d] * o[d];
    ss += __shfl_xor(ss, 1);
    float r = rsqrtf(ss * (1.f / 128.f) + EPS) * (1.f - LAM_INIT);
#pragma unroll
    for (int d = 0; d < 64; ++d) {
        int c = h * 128 + m * 64 + d;
        float g = bf2f(G[trow * DM + c]);
        float sg = g / (1.f + __expf(-g));
        OG[trow * DM + c] = f2bf(o[d] * r * subln[m * 64 + d] * sg);
    }
}
#endif
namespace pg8 {
#define PG8_LAS __attribute__((address_space(3)))
typedef unsigned short bf16_t;
typedef short bf16x8 __attribute__((ext_vector_type(8)));
typedef float f32x4 __attribute__((ext_vector_type(4)));
typedef unsigned u32x4 __attribute__((ext_vector_type(4)));
constexpr int BM = 256, BK = 64, HALF = 128, HTB = HALF * BK * 2  , STAGE_BYTES = 8 * HTB, NXCD = 8, WGM = 8;

__host__ __device__ __forceinline__ int lds_byte(int r, int c) { const int st = (r >> 4) * 2 + (c >> 5), rr = r & 15, cc = c & 31, ob = rr * 64 + cc * 2; return st * 1024 + (ob ^ (((ob >> 9) & 1) << 5)); }
__host__ __device__ __forceinline__ void stage_rc(int b, int& R, int& C) { const int st = b / 1024, sb = b % 1024, swz = sb ^ (((sb >> 9) & 1) << 5); R = (st >> 1) * 16 + swz / 64; C = (st & 1) * 32 + (swz % 64) / 2; }
__host__ __device__ __forceinline__ int perm32(int rho) { const int n = rho >> 4, i = rho & 15; return 8 * (i >> 2) + 4 * n + (i & 3); }

struct Unit { int pm, pn; };
struct Gemm { const bf16_t* A; const bf16_t* Bt; int M, N, K; };

struct StaticOrder {
    int nM, nN, nwg, G, c;
    __host__ __device__ void init(int M, int N, int G_, int c_) { nM = M / BM; nN = N / BM; nwg = nM * nN; G = G_; c = c_; }
    __host__ __device__ bool next(int i, Unit& u) const {
        const long L = (long)i * G + c; if (L >= nwg) return false;
        int wgid = (int)L; { const int q = nwg / NXCD, r = nwg % NXCD, xcd = wgid % NXCD, off = wgid / NXCD; wgid = (xcd < r ? xcd * (q + 1) : r * (q + 1) + (xcd - r) * q) + off; }
        const int nig = WGM * nN, gid = wgid / nig, fm = gid * WGM, gsz = (nM - fm) < WGM ? (nM - fm) : WGM;
        u.pm = fm + ((wgid % nig) % gsz); u.pn = (wgid % nig) / gsz; return true;
    }
    __device__ __forceinline__ void a_ready(const Unit&) const {}
    __device__ __forceinline__ void done(const Unit&) const {}
};

__device__ __forceinline__ unsigned cvt_pk_bf16(float lo, float hi) { unsigned r; asm volatile("v_cvt_pk_bf16_f32 %0, %1, %2" : "=v"(r) : "v"(lo), "v"(hi)); return r; }
struct EpiSplit {
    static constexpr bool PERM = true, AFTER_DRAIN = false;
    bf16_t* O; size_t split_stride; int scale_split; float scale; unsigned rope_mask; const float* cs;
    __device__ __forceinline__ void operator()(const f32x4 (&acc)[2][2][4][2], const Unit& u, int wr, int wc, int fr, int fq) const {
        const int row0 = u.pm * BM + wr * 64 + fr; int colt = u.pn * BM;
        const int t = colt >> 10; bf16_t* base = O + (size_t)t * split_stride; colt &= 1023;
        const float sc = (t == scale_split) ? scale : 1.f;
        const int col0 = colt + wc * 32 + 8 * fq;
        const bool rope = ((rope_mask >> t) & 1u) && !(wc & 1);
#pragma unroll
        for (int ai = 0; ai < 2; ++ai)
#pragma unroll
            for (int m = 0; m < 4; ++m) {
                const int row = row0 + ai * HALF + m * 16;
                bf16_t* rowp = base + (size_t)row * 1024 + col0;
                f32x4 c0 = {1.f, 1.f, 1.f, 1.f}, c1 = c0, s0 = {0.f, 0.f, 0.f, 0.f}, s1 = s0;
                if (rope) { const f32x4* cp = (const f32x4*)(cs + (size_t)row * 16); c0 = cp[0]; c1 = cp[1]; s0 = cp[2]; s1 = cp[3];
                    if (fq == 0) { s0 = -s0; s1 = -s1; } else if (fq >= 2) { c0 = (f32x4){1.f, 1.f, 1.f, 1.f}; c1 = c0; s0 = (f32x4){0.f, 0.f, 0.f, 0.f}; s1 = s0; } }
#pragma unroll
                for (int bj = 0; bj < 2; ++bj) { f32x4 v0 = acc[ai][bj][m][0], v1 = acc[ai][bj][m][1];
                    if (rope) { f32x4 p0, p1;
#pragma unroll
                        for (int e = 0; e < 4; ++e) { p0[e] = __shfl_xor(v0[e], 16); p1[e] = __shfl_xor(v1[e], 16); }
                        v0 = v0 * c0 + p0 * s0; v1 = v1 * c1 + p1 * s1; }
                    v0 = v0 * sc; v1 = v1 * sc; u32x4 w; w.x = cvt_pk_bf16(v0[0], v0[1]); w.y = cvt_pk_bf16(v0[2], v0[3]); w.z = cvt_pk_bf16(v1[0], v1[1]); w.w = cvt_pk_bf16(v1[2], v1[3]);
                    *(u32x4*)(rowp + bj * HALF) = w; } }
    }
};
struct EpiF32 {
    static constexpr bool PERM = false, AFTER_DRAIN = false;
    float* C; int ldc;
    __device__ __forceinline__ void operator()(const f32x4 (&acc)[2][2][4][2], const Unit& u, int wr, int wc, int fr, int fq) const {
        const int row0 = u.pm * BM + wr * 64 + fr, col0 = u.pn * BM + wc * 32 + 4 * fq;
#pragma unroll
        for (int ai = 0; ai < 2; ++ai)
#pragma unroll
            for (int m = 0; m < 4; ++m) { float* rowp = C + (size_t)(row0 + ai * HALF + m * 16) * ldc + col0;
#pragma unroll
                for (int bj = 0; bj < 2; ++bj)
#pragma unroll
                    for (int n = 0; n < 2; ++n) *(f32x4*)(rowp + bj * HALF + n * 16) = acc[ai][bj][m][n]; }
    }
};
template <class Epi, class Sched, bool ALIGN_EPI = false, bool SP2 = false>
__device__ __forceinline__ void gemm_phase(PG8_LAS unsigned char* lds, const Gemm g, const Sched& S, const Epi& E) {
    const int tid = threadIdx.x, wid = __builtin_amdgcn_readfirstlane(tid >> 6), lane = tid & 63, wr = wid >> 2, wc = wid & 3, fr = lane & 15, fq = lane >> 4;
    const int K = g.K, nt = K / BK;
    unsigned voffA[2], voffB[2];
#pragma unroll
    for (int i = 0; i < 2; ++i) { int R, C; stage_rc(tid * 16 + i * 8192, R, C); const int Rb = Epi::PERM ? ((R & ~31) + perm32(R & 31)) : R;
        voffA[i] = (unsigned)(R * K + C) * 2u; voffB[i] = (unsigned)(Rb * K + C) * 2u; }
    const size_t kstep = (size_t)(BK * 2);
    const size_t hstep = (size_t)HALF * K * 2;
    const size_t tstep = 2 * hstep;
    const unsigned ldsw = (unsigned)wid * 1024u;
    const int aoff = lds_byte(wr * 64 + fr, fq * 8), boff = lds_byte(wc * 32 + fr, fq * 8);
#define PG8_SA(b, h) (((b) * 2 + (h)) * HTB)
#define PG8_SB(b, h) ((4 + (b) * 2 + (h)) * HTB)
#define PG8_STAGE(bufoff, gbase, voff) do { _Pragma("unroll") for (int _i = 0; _i < 2; ++_i) \
        __builtin_amdgcn_global_load_lds((const unsigned*)((const char*)(gbase) + (voff)[_i]), (PG8_LAS unsigned*)(lds + (bufoff) + ldsw + _i * 8192), 16, 0, 0); } while (0)
#define PG8_LDA(dst, b, h) do { _Pragma("unroll") for (int m = 0; m < 4; ++m) _Pragma("unroll") for (int k = 0; k < 2; ++k) dst[m][k] = *(const PG8_LAS bf16x8*)(lds + PG8_SA(b, h) + aoff + m * 2048 + k * 1024); } while (0)
#define PG8_LDB(dst, b, h) do { _Pragma("unroll") for (int n = 0; n < 2; ++n) _Pragma("unroll") for (int k = 0; k < 2; ++k) dst[n][k] = *(const PG8_LAS bf16x8*)(lds + PG8_SB(b, h) + boff + n * 2048 + k * 1024); } while (0)
#define PG8_MMA(ai, bj, At, Bt) do { __builtin_amdgcn_s_setprio(1); _Pragma("unroll") for (int m = 0; m < 4; ++m) _Pragma("unroll") for (int n = 0; n < 2; ++n) _Pragma("unroll") for (int k = 0; k < 2; ++k) \
        acc[ai][bj][m][n] = __builtin_amdgcn_mfma_f32_16x16x32_bf16(Bt[n][k], At[m][k], acc[ai][bj][m][n], 0, 0, 0); __builtin_amdgcn_s_setprio(0); } while (0)
#define PG8_WAIT_V(n) asm volatile("s_waitcnt vmcnt(" #n ")" ::: "memory")
#define PG8_WAIT_L(n) asm volatile("s_waitcnt lgkmcnt(" #n ")" ::: "memory")
#define PG8_BAR __builtin_amdgcn_s_barrier()
#define PG8_SCHED __builtin_amdgcn_sched_barrier(0)
    Unit cur, nxt; int ui = 0;
    if (!S.next(0, cur)) return;
    f32x4 acc[2][2][4][2];
#pragma unroll
    for (int a = 0; a < 2; ++a)
#pragma unroll
        for (int b = 0; b < 2; ++b)
#pragma unroll
            for (int m = 0; m < 4; ++m)
#pragma unroll
                for (int n = 0; n < 2; ++n) acc[a][b][m][n] = (f32x4){0.f, 0.f, 0.f, 0.f};
    bf16x8 At[4][2], B0[2][2], B1[2][2];
    const char* cA = (const char*)g.A + (size_t)cur.pm * tstep; const char* cB = (const char*)g.Bt + (size_t)cur.pn * tstep;
    S.a_ready(cur);
    if constexpr (SP2) {
        PG8_STAGE(PG8_SB(0, 0), cB, voffB); PG8_STAGE(PG8_SB(0, 1), cB + hstep, voffB); PG8_STAGE(PG8_SA(0, 0), cA, voffA); PG8_STAGE(PG8_SA(0, 1), cA + hstep, voffA);
        if (wr == 1) PG8_BAR;
        PG8_WAIT_V(2); PG8_BAR;
        PG8_STAGE(PG8_SB(1, 0), cB + kstep, voffB); PG8_STAGE(PG8_SA(1, 0), cA + kstep, voffA); PG8_STAGE(PG8_SB(1, 1), cB + hstep + kstep, voffB);
        PG8_WAIT_V(6); PG8_BAR;
    } else {
        PG8_STAGE(PG8_SB(0, 0), cB, voffB); PG8_STAGE(PG8_SA(0, 0), cA, voffA); PG8_STAGE(PG8_SB(0, 1), cB + hstep, voffB); PG8_STAGE(PG8_SA(0, 1), cA + hstep, voffA);
        if (wr == 1) PG8_BAR;
        PG8_WAIT_V(4); PG8_BAR;
        PG8_STAGE(PG8_SB(1, 0), cB + kstep, voffB); PG8_STAGE(PG8_SA(1, 0), cA + kstep, voffA); PG8_STAGE(PG8_SB(1, 1), cB + hstep + kstep, voffB);
        PG8_WAIT_V(6); PG8_BAR;
    }
    for (;;) {
        const bool has_next = S.next(ui + 1, nxt);
        const char* nA = has_next ? (const char*)g.A + (size_t)nxt.pm * tstep : cA; const char* nB = has_next ? (const char*)g.Bt + (size_t)nxt.pn * tstep : cB;
        for (int t = 0; t < nt; t += 2) {
            const bool last = (t == nt - 2);
            const char* a1 = cA + (size_t)(t + 1) * kstep;
            const char* a2 = last ? nA : cA + (size_t)(t + 2) * kstep; const char* b2 = last ? nB : cB + (size_t)(t + 2) * kstep;
            const char* a3 = a2 + kstep; const char* b3 = b2 + kstep;
            if (last && has_next) S.a_ready(nxt);
            if constexpr (SP2) {
            PG8_LDB(B0, 0, 0); PG8_LDB(B1, 0, 1); PG8_SCHED; PG8_LDA(At, 0, 0); PG8_STAGE(PG8_SA(1, 1), a1 + hstep, voffA);
            PG8_WAIT_V(8); PG8_WAIT_L(0); PG8_BAR; PG8_MMA(0, 0, At, B0); PG8_MMA(0, 1, At, B1); PG8_BAR; PG8_SCHED;
            PG8_LDA(At, 0, 1); PG8_STAGE(PG8_SB(0, 0), b2, voffB); PG8_STAGE(PG8_SB(0, 1), b2 + hstep, voffB); PG8_STAGE(PG8_SA(0, 0), a2, voffA);
            PG8_WAIT_V(8); PG8_WAIT_L(0); PG8_BAR; PG8_MMA(1, 0, At, B0); PG8_MMA(1, 1, At, B1); PG8_BAR; PG8_SCHED;
            PG8_LDB(B0, 1, 0); PG8_LDB(B1, 1, 1); PG8_SCHED; PG8_LDA(At, 1, 0); PG8_STAGE(PG8_SA(0, 1), a2 + hstep, voffA);
            PG8_WAIT_V(8); PG8_WAIT_L(0); PG8_BAR; PG8_MMA(0, 0, At, B0); PG8_MMA(0, 1, At, B1); PG8_BAR; PG8_SCHED;
            PG8_LDA(At, 1, 1); PG8_STAGE(PG8_SB(1, 0), b3, voffB); PG8_STAGE(PG8_SB(1, 1), b3 + hstep, voffB); PG8_STAGE(PG8_SA(1, 0), a3, voffA);
            PG8_WAIT_V(8); PG8_WAIT_L(0); PG8_BAR; PG8_MMA(1, 0, At, B0); PG8_MMA(1, 1, At, B1); PG8_BAR; PG8_SCHED;
            } else {
            PG8_LDB(B0, 0, 0); PG8_SCHED; PG8_LDA(At, 0, 0); PG8_STAGE(PG8_SA(1, 1), a1 + hstep, voffA);
            PG8_WAIT_L(8); PG8_BAR; PG8_WAIT_L(0); PG8_MMA(0, 0, At, B0); PG8_BAR; PG8_SCHED;
            PG8_LDB(B1, 0, 1); PG8_STAGE(PG8_SB(0, 0), b2, voffB);
            PG8_BAR; PG8_WAIT_L(0); PG8_MMA(0, 1, At, B1); PG8_BAR;
            PG8_LDA(At, 0, 1); PG8_STAGE(PG8_SA(0, 0), a2, voffA);
            PG8_BAR; PG8_WAIT_L(0); PG8_MMA(1, 0, At, B0); PG8_BAR; PG8_SCHED;
            PG8_STAGE(PG8_SB(0, 1), b2 + hstep, voffB);
            PG8_WAIT_V(6); PG8_BAR; PG8_MMA(1, 1, At, B1); PG8_BAR;
            PG8_LDB(B0, 1, 0); PG8_SCHED; PG8_LDA(At, 1, 0); PG8_STAGE(PG8_SA(0, 1), a2 + hstep, voffA);
            PG8_WAIT_L(8); PG8_BAR; PG8_WAIT_L(0); PG8_MMA(0, 0, At, B0); PG8_BAR; PG8_SCHED;
            PG8_LDB(B1, 1, 1); PG8_STAGE(PG8_SB(1, 0), b3, voffB);
            PG8_BAR; PG8_WAIT_L(0); PG8_MMA(0, 1, At, B1); PG8_BAR;
            PG8_LDA(At, 1, 1); PG8_STAGE(PG8_SA(1, 0), a3, voffA);
            PG8_BAR; PG8_WAIT_L(0); PG8_MMA(1, 0, At, B0); PG8_BAR; PG8_SCHED;
            PG8_STAGE(PG8_SB(1, 1), b3 + hstep, voffB);
            PG8_WAIT_V(6); PG8_BAR; PG8_MMA(1, 1, At, B1); PG8_BAR;
            }
        }
        if constexpr (ALIGN_EPI) { if (wr == 0) PG8_BAR; }
        if constexpr (!Epi::AFTER_DRAIN) { E(acc, cur, wr, wc, fr, fq); S.done(cur); }
        if (!has_next) break;
#pragma unroll
        for (int a = 0; a < 2; ++a)
#pragma unroll
            for (int b = 0; b < 2; ++b)
#pragma unroll
                for (int m = 0; m < 4; ++m)
#pragma unroll
                    for (int n = 0; n < 2; ++n) acc[a][b][m][n] = (f32x4){0.f, 0.f, 0.f, 0.f};
        cur = nxt; cA = nA; cB = nB; ++ui;
        if constexpr (ALIGN_EPI) { if (wr == 1) PG8_BAR; }
    }
    PG8_WAIT_V(0);
    if constexpr (!ALIGN_EPI) { if (wr == 0) PG8_BAR; }
    PG8_BAR;
    if constexpr (Epi::AFTER_DRAIN) { E.fused(acc, cur, wr, wc, fr, fq, lds, wid, lane); S.done(cur); }
#undef PG8_SA
#undef PG8_SB
#undef PG8_STAGE
#undef PG8_LDA
#undef PG8_LDB
#undef PG8_MMA
#undef PG8_WAIT_V
#undef PG8_WAIT_L
#undef PG8_BAR
#undef PG8_SCHED
}
}
constexpr int NWAVES = 8;
constexpr size_t MiB = 1u << 20;
constexpr size_t WS_CTL = 0, CTL_ZERO_BYTES = 1 * MiB;
constexpr size_t WS_WIN_A = 2 * MiB, WS_WOUT_A = 10 * MiB, WS_WCAT = 12 * MiB, WS_WOUT_B = 20 * MiB, WS_CS = 22 * MiB;
constexpr size_t WS_XN = 32 * MiB, WS_S0 = 96 * MiB, WS_S1 = 160 * MiB, WS_S2 = 224 * MiB, WS_S3 = 288 * MiB, WS_Y = 352 * MiB, WS_END = 480 * MiB;
constexpr size_t SPL = (size_t)T * DM;
constexpr int CW_TMO = 0, CW_CODE = 1, CW_BAR = 4096;
constexpr int N_BAR_REGIONS = 3;
constexpr int RING_OFF = 0, RING_BYTES = 131072;
constexpr int LDSCTL_OFF = RING_BYTES, MISC_OFF = LDSCTL_OFF + 320;
constexpr int LDS_BYTES = 147456;

#define GAS __attribute__((address_space(1)))
#define LAS __attribute__((address_space(3)))
typedef unsigned v4u __attribute__((ext_vector_type(4)));
typedef float f32x4 __attribute__((ext_vector_type(4)));
typedef short bf16x8 __attribute__((ext_vector_type(8)));
typedef GAS unsigned gu32;
#define RLX_AGENT __ATOMIC_RELAXED, __HIP_MEMORY_SCOPE_AGENT
#define LDS_WAIT() asm volatile("s_waitcnt lgkmcnt(0)" ::: "memory")
#define VM_WAIT() asm volatile("s_waitcnt vmcnt(0)" ::: "memory")
__device__ __forceinline__ unsigned pk2(float lo, float hi) { return (unsigned)f2bf(lo) | ((unsigned)f2bf(hi) << 16); }
__device__ __forceinline__ float wave_sum(float v) {
#pragma unroll
    for (int o = 1; o < 64; o <<= 1) v += __shfl_xor(v, o);
    return v;
}
#define XB_TMO      128
#define XB_XCNT(j)  (256  + 64 * (j))
#define XB_XSUB(j)  (1280 + 64 * (j))
#define XB_XGEN(j)  (2304 + 64 * (j))
#define XB_TOP      3328
#define XB_TOPGEN   3392
#define XCD_BAR_WORDS 3456
#define XB_SPIN_CAP (1u << 18)

__device__ __forceinline__ unsigned xb_ld(unsigned* p)              { return __hip_atomic_load(p, __ATOMIC_RELAXED, __HIP_MEMORY_SCOPE_AGENT); }
__device__ __forceinline__ unsigned xb_add(unsigned* p, unsigned v) { return __hip_atomic_fetch_add(p, v, __ATOMIC_RELAXED, __HIP_MEMORY_SCOPE_AGENT); }
__device__ __forceinline__ unsigned xb_xcc_id() { return (unsigned)__builtin_amdgcn_s_getreg((3 << 11) | 20) & 0xFu; }
#define XB_SPIN(cond, bar) do { unsigned _sp = 0; while (cond) { __builtin_amdgcn_s_sleep(1); \
    if ((++_sp & 255u) == 0u) { if (xb_ld(&(bar)[XB_TMO])) break; if (_sp > XB_SPIN_CAP) { atomicAdd(&(bar)[XB_TMO], 1u); break; } } } } while (0)

struct XcdBarrier {
    unsigned* bar; unsigned x;
    volatile LAS unsigned* st;
};

__device__ __forceinline__ XcdBarrier xcd_barrier_post(unsigned* bar, volatile LAS unsigned* st) {
    XcdBarrier b; b.bar = bar; b.x = xb_xcc_id(); b.st = st;
    if (threadIdx.x == 0) (void)xb_add(&bar[XB_XCNT(b.x)], 1u);
    return b;
}
__device__ __forceinline__ void xcd_barrier_complete(unsigned* bar, unsigned x, unsigned& nloc, unsigned& nx) {
    const unsigned G = gridDim.x * gridDim.y * gridDim.z;
    unsigned sum, cnt, mine, sp = 0u;
    for (;;) {
        sum = 0u; cnt = 0u; mine = 0u;
#pragma unroll
        for (unsigned j = 0; j < 16; ++j) { const unsigned c = xb_ld(&bar[XB_XCNT(j)]); sum += c; cnt += (c > 0u) ? 1u : 0u; mine = (j == x) ? c : mine; }
        if (sum == G) break;
        __builtin_amdgcn_s_sleep(1);
        if ((++sp & 255u) == 0u) { if (xb_ld(&bar[XB_TMO])) break; if (sp > XB_SPIN_CAP) { atomicAdd(&bar[XB_TMO], 1u); break; } }
    }
    nloc = mine > 0u ? mine : 1u; nx = cnt > 0u ? cnt : 1u;
}

__device__ __forceinline__ void xcd_barrier(const XcdBarrier& b) {
    asm volatile("s_waitcnt vmcnt(0)" ::: "memory");
    __syncthreads();
    if (threadIdx.x == 0) {
        unsigned* bar = b.bar;
        __builtin_amdgcn_s_waitcnt(0);
        unsigned nloc = b.st[0], nx = b.st[1];
        if (nloc == 0u) { xcd_barrier_complete(bar, b.x, nloc, nx); b.st[0] = nloc; b.st[1] = nx; }
        const unsigned old = xb_add(&bar[XB_XSUB(b.x)], 1u);
        const unsigned gen = old / nloc;
        if (old + 1u == (gen + 1u) * nloc) {
            __builtin_amdgcn_fence(__ATOMIC_RELEASE, "agent");
            asm volatile("s_waitcnt vmcnt(0)" ::: "memory");
            const unsigned og = xb_add(&bar[XB_TOP], 1u);
            const unsigned tg = og / nx;
            if (og + 1u == (tg + 1u) * nx) xb_add(&bar[XB_TOPGEN], 1u);
            else XB_SPIN(xb_ld(&bar[XB_TOPGEN]) == tg, bar);
            __builtin_amdgcn_fence(__ATOMIC_ACQUIRE, "agent");
            xb_add(&bar[XB_XGEN(b.x)], 1u);
            asm volatile("s_waitcnt vmcnt(0)" ::: "memory");
        } else {
            XB_SPIN(xb_ld(&bar[XB_XGEN(b.x)]) == gen, bar);
            __builtin_amdgcn_fence(__ATOMIC_ACQUIRE, "agent");
            asm volatile("s_waitcnt vmcnt(0)" ::: "memory");
        }
    }
    __syncthreads();
}
struct Frame {
    LAS unsigned char* lds;
    volatile LAS unsigned* MISC;
    gu32* ctl;
    int tid, lane, wave, vcu, G;
};

__device__ __forceinline__ void p0_transpose_item(const float* W, const float* g, int K, int N, bf16_t* WT, int row_off, LAS float* scr, int item, int lane) {
    const int nblk = N / 32, kb = item / nblk, nb = item % nblk, k0 = 64 * kb, n0 = 32 * nb;
#pragma unroll 8
    for (int i = 0; i < 32; ++i) { const int kk = 2 * i + (lane >> 5); const float gv = g ? g[k0 + kk] : 1.f; scr[kk * 33 + (lane & 31)] = W[(size_t)(k0 + kk) * N + n0 + (lane & 31)] * gv; }
    LDS_WAIT(); asm volatile("" ::: "memory");
    const int c = lane & 7;
#pragma unroll
    for (int j = 0; j < 4; ++j) { const int n = (lane >> 3) + 8 * j; const LAS float* s = scr + (8 * c) * 33 + n;
        v4u o; o.x = pk2(s[0 * 33], s[1 * 33]); o.y = pk2(s[2 * 33], s[3 * 33]); o.z = pk2(s[4 * 33], s[5 * 33]); o.w = pk2(s[6 * 33], s[7 * 33]);
        *(GAS v4u*)(WT + (size_t)(row_off + n0 + n) * K + k0 + 8 * c) = o; }
    LDS_WAIT(); asm volatile("" ::: "memory");
}
__device__ __forceinline__ void rms_row_to_bf16(int lane, const float* xrow, bf16_t* orow) {
    const GAS f32x4* xr = (const GAS f32x4*)xrow + lane;
    f32x4 v[4]; float s = 0.f;
#pragma unroll
    for (int j = 0; j < 4; ++j) { v[j] = xr[64 * j]; s += (v[j].x * v[j].x + v[j].y * v[j].y) + (v[j].z * v[j].z + v[j].w * v[j].w); }
    const float r = rsqrtf(wave_sum(s) * (1.f / DM) + EPS);
    GAS unsigned long long* o8 = (GAS unsigned long long*)orow + lane;
#pragma unroll
    for (int j = 0; j < 4; ++j) o8[64 * j] = (unsigned long long)pk2(v[j].x * r, v[j].y * r) | ((unsigned long long)pk2(v[j].z * r, v[j].w * r) << 32);
}
__device__ __forceinline__ void resnorm_row(int lane, const float* hin, const float* y, const float* g, float* hout, bf16_t* hn) {
    const GAS f32x4* yr = (const GAS f32x4*)y + lane; const GAS f32x4* hr = (const GAS f32x4*)hin + lane; const GAS f32x4* gr = (const GAS f32x4*)g + lane;
    f32x4 v[4], hv[4]; float s = 0.f;
#pragma unroll
    for (int j = 0; j < 4; ++j) { v[j] = yr[64 * j]; hv[j] = hr[64 * j]; s += (v[j].x * v[j].x + v[j].y * v[j].y) + (v[j].z * v[j].z + v[j].w * v[j].w); }
    const float r = rsqrtf(wave_sum(s) * (1.f / DM) + EPS);
    float s2 = 0.f;
    GAS f32x4* orow = (GAS f32x4*)hout + lane;
#pragma unroll
    for (int j = 0; j < 4; ++j) { v[j] = hv[j] + v[j] * r * gr[64 * j]; s2 += (v[j].x * v[j].x + v[j].y * v[j].y) + (v[j].z * v[j].z + v[j].w * v[j].w); orow[64 * j] = v[j]; }
    if (hn) {
        const float r2 = rsqrtf(wave_sum(s2) * (1.f / DM) + EPS);
        GAS unsigned long long* o8 = (GAS unsigned long long*)hn + lane;
#pragma unroll
        for (int j = 0; j < 4; ++j) o8[64 * j] = (unsigned long long)pk2(v[j].x * r2, v[j].y * r2) | ((unsigned long long)pk2(v[j].z * r2, v[j].w * r2) << 32);
    }
}

struct Args { const float* in[18]; float* out; unsigned char* ws; int ph_lo, ph_hi, li, pad; };

__global__ void __launch_bounds__(NWAVES * 64, 2) mega_fwd(Args args) {
    extern __shared__ __attribute__((aligned(16))) unsigned char lds[];
    Frame F;
    F.lds = (LAS unsigned char*)lds;
    F.MISC = (volatile LAS unsigned*)(F.lds + MISC_OFF);
    F.tid = threadIdx.x; F.lane = F.tid & 63; F.wave = __builtin_amdgcn_readfirstlane(F.tid >> 6);
    F.G = gridDim.x; { const int bx = blockIdx.x; F.vcu = (F.G % 8 == 0) ? (bx % 8) * (F.G / 8) + bx / 8 : bx; }
    unsigned char* ws = args.ws;
    F.ctl = (gu32*)(ws + WS_CTL);
    const float* x = args.in[0]; const int* pos = (const int*)args.in[1];
    const float* a_norm_pre = args.in[2]; const float* a_w_in = args.in[3]; const float* a_rel_bias = args.in[4];
    const float* a_w_out = args.in[5]; const float* a_norm_post = args.in[6]; const float* kv_norm = args.in[7];
    const float* kv_w = args.in[8]; const float* b_norm_pre = args.in[9]; const float* b_w_in = args.in[10];
    const float* lq1 = args.in[11]; const float* lk1 = args.in[12]; const float* lq2 = args.in[13]; const float* lk2 = args.in[14];
    const float* b_subln = args.in[15]; const float* b_w_out = args.in[16]; const float* b_norm_post = args.in[17];
    float* out = args.out;
    bf16_t* Wt_in_a = (bf16_t*)(ws + WS_WIN_A); bf16_t* Wt_out_a = (bf16_t*)(ws + WS_WOUT_A); bf16_t* Wt_cat = (bf16_t*)(ws + WS_WCAT); bf16_t* Wt_out_b = (bf16_t*)(ws + WS_WOUT_B);
    float* cs = (float*)(ws + WS_CS);
    bf16_t* XN = (bf16_t*)(ws + WS_XN); bf16_t* S0 = (bf16_t*)(ws + WS_S0); bf16_t* S2 = (bf16_t*)(ws + WS_S2);
    float* Y = (float*)(ws + WS_Y);
    (void)a_rel_bias; (void)lq1; (void)lk1; (void)lq2; (void)lk2; (void)b_subln;

    for (int u = F.tid; u < (LDS_BYTES - LDSCTL_OFF) / 4; u += NWAVES * 64) ((LAS unsigned*)(F.lds + LDSCTL_OFF))[u] = 0u;
    __syncthreads();
    XcdBarrier bar = xcd_barrier_post((unsigned*)(F.ctl + CW_BAR) + args.li * XCD_BAR_WORDS, F.MISC + 8);
    const int lo = args.ph_lo, hi = args.ph_hi;
#define IN(k) (lo <= (k) && (k) < hi)
#define BOTH(k) (IN(k) && IN((k) + 1))
    const int gw = F.vcu * NWAVES + F.wave, NGW = F.G * NWAVES;

    if (IN(0)) {
        LAS float* scr = (LAS float*)(F.lds + RING_OFF + F.wave * 16384);
        constexpr int I_IN = 16 * 128, I_OUT = 16 * 32, I_KV = 16 * 64;
        constexpr int NITEMS = I_IN + I_OUT + 2 * I_KV + I_OUT;
        for (int it = gw; it < NITEMS; it += NGW) {
            int r = it;
            if (r < I_IN) { p0_transpose_item(a_w_in, a_norm_pre, 1024, 4096, Wt_in_a, 0, scr, r, F.lane); continue; } r -= I_IN;
            if (r < I_OUT) { p0_transpose_item(a_w_out, nullptr, 1024, 1024, Wt_out_a, 0, scr, r, F.lane); continue; } r -= I_OUT;
            if (r < I_KV) { p0_transpose_item(kv_w, kv_norm, 1024, 2048, Wt_cat, 0, scr, r, F.lane); continue; } r -= I_KV;
            if (r < I_KV) { p0_transpose_item(b_w_in, b_norm_pre, 1024, 2048, Wt_cat, 2048, scr, r, F.lane); continue; } r -= I_KV;
            p0_transpose_item(b_w_out, nullptr, 1024, 1024, Wt_out_b, 0, scr, r, F.lane);
        }
        for (int m = gw; m < T; m += NGW) rms_row_to_bf16(F.lane, x + (size_t)m * DM, XN + (size_t)m * DM);
        for (int idx = blockIdx.x * 512 + F.tid; idx < T * 8; idx += F.G * 512) {
            const int t = idx >> 3, i = idx & 7;
            const float inv = powf(500000.0f, -(float)i * 0.125f);
            const float ang = (float)pos[t] * inv;
            cs[t * 16 + i] = cosf(ang); cs[t * 16 + 8 + i] = sinf(ang);
        }
        if (BOTH(0)) xcd_barrier(bar);
    }
    if (IN(1)) {
        pg8::Gemm g{XN, Wt_in_a, T, 4096, 1024}; pg8::StaticOrder S; S.init(T, 4096, F.G, (int)blockIdx.x);
        pg8::EpiSplit E{S0, SPL, 0, C2, 0u, cs};
        pg8::gemm_phase<pg8::EpiSplit, pg8::StaticOrder, true, true>(F.lds + RING_OFF, g, S, E);
        if (BOTH(1)) xcd_barrier(bar);
    }
    if (IN(3)) {
        pg8::Gemm g{S0, Wt_out_a, T, 1024, 1024}; pg8::StaticOrder S; S.init(T, 1024, F.G, (int)blockIdx.x);
        pg8::EpiF32 E{Y, 1024};
        pg8::gemm_phase<pg8::EpiF32, pg8::StaticOrder, true, true>(F.lds + RING_OFF, g, S, E);
        if (BOTH(3)) xcd_barrier(bar);
    }
    if (IN(4)) {
        for (int m = gw; m < T; m += NGW) resnorm_row(F.lane, x + (size_t)m * DM, Y + (size_t)m * DM, a_norm_post, out + (size_t)m * DM, XN + (size_t)m * DM);
        if (BOTH(4)) xcd_barrier(bar);
    }
    if (IN(5)) {
        pg8::Gemm g{XN, Wt_cat, T, 4096, 1024}; pg8::StaticOrder S; S.init(T, 4096, F.G, (int)blockIdx.x);
        pg8::EpiSplit E{S0, SPL, 2, C2, 0x5u, cs};
        pg8::gemm_phase<pg8::EpiSplit, pg8::StaticOrder, true, true>(F.lds + RING_OFF, g, S, E);
        if (BOTH(5)) xcd_barrier(bar);
    }
    if (IN(7)) {
        pg8::Gemm g{S2, Wt_out_b, T, 1024, 1024}; pg8::StaticOrder S; S.init(T, 1024, F.G, (int)blockIdx.x);
        pg8::EpiF32 E{Y, 1024};
        pg8::gemm_phase<pg8::EpiF32, pg8::StaticOrder, true, true>(F.lds + RING_OFF, g, S, E);
        if (BOTH(7)) xcd_barrier(bar);
    }
    if (IN(8)) {
        for (int m = gw; m < T; m += NGW) resnorm_row(F.lane, out + (size_t)m * DM, Y + (size_t)m * DM, b_norm_post, out + (size_t)m * DM, nullptr);
    }
#undef IN
#undef BOTH
}

extern "C" void kernel_launch(void* const* d_in, const int* in_sizes, int n_in, void* d_out, int out_size, void* d_ws, size_t ws_size, hipStream_t stream) {
    static int grid = 0;
    if (grid == 0) {
        if (n_in != 18 || out_size != T * DM || ws_size < WS_END) { fprintf(stderr, "kernel_launch: unexpected shapes (n_in %d out %d ws %zu)\n", n_in, out_size, ws_size); grid = -1; return; }
        int dev = 0, cus = 0;
        if (hipGetDevice(&dev) != hipSuccess || hipDeviceGetAttribute(&cus, hipDeviceAttributeMultiprocessorCount, dev) != hipSuccess) { grid = -1; return; }
        if (hipFuncSetAttribute((const void*)mega_fwd, hipFuncAttributeMaxDynamicSharedMemorySize, LDS_BYTES) != hipSuccess) { fprintf(stderr, "kernel_launch: hipFuncSetAttribute failed\n"); grid = -1; return; }
        grid = cus;
    }
    if (grid < 0) return;
    hipMemsetAsync((char*)d_ws + WS_CTL, 0, CTL_ZERO_BYTES, stream);
    Args a{};
    for (int i = 0; i < 18; ++i) a.in[i] = (const float*)d_in[i];
    a.out = (float*)d_out; a.ws = (unsigned char*)d_ws;
#if HYBRID
    unsigned char* ws = (unsigned char*)d_ws;
    bf16_t* S0 = (bf16_t*)(ws + WS_S0); bf16_t* S1 = (bf16_t*)(ws + WS_S1); bf16_t* S2 = (bf16_t*)(ws + WS_S2); bf16_t* S3 = (bf16_t*)(ws + WS_S3);
    a.ph_lo = 0; a.ph_hi = 2; a.li = 0; hipLaunchKernelGGL(mega_fwd, dim3(grid), dim3(NWAVES * 64), LDS_BYTES, stream, a);
    attn_a_naive<<<T * 16 / 64, 64, 0, stream>>>(S0, S1, S2, S3, (const int*)d_in[1], (const float*)d_in[4], S0);
    a.ph_lo = 3; a.ph_hi = 6; a.li = 1; hipLaunchKernelGGL(mega_fwd, dim3(grid), dim3(NWAVES * 64), LDS_BYTES, stream, a);
    attn_b_naive<<<T * 8 * 2 / 64, 64, 0, stream>>>(S2, S0, S1, S3, (const float*)d_in[11], (const float*)d_in[12], (const float*)d_in[13], (const float*)d_in[14], (const float*)d_in[15], S2);
    a.ph_lo = 7; a.ph_hi = 9; a.li = 2; hipLaunchKernelGGL(mega_fwd, dim3(grid), dim3(NWAVES * 64), LDS_BYTES, stream, a);
#else
    a.ph_lo = 0; a.ph_hi = 9; a.li = 0; hipLaunchKernelGGL(mega_fwd, dim3(grid), dim3(NWAVES * 64), LDS_BYTES, stream, a);
#endif
}
```

```cpp
#include <hip/hip_runtime.h>
#include <cstdint>
#include <cstdio>

#ifndef HYBRID
#define HYBRID 0
#endif

typedef unsigned short bf16_t;
constexpr int BATCH = 16, SEQ = 2048, DM = 1024, T = BATCH * SEQ;
constexpr int CHUNK = 64, PAST = 8, MAXREL = 128, NREL = 257;
constexpr float EPS = 1e-6f;
constexpr float LAM_INIT = 0.35550906759096924f;
constexpr float LOG2E = 1.4426950408889634f;
constexpr float C2 = 0.125f * LOG2E;

__device__ __forceinline__ float bf2f(bf16_t v) { return __uint_as_float((unsigned)v << 16); }
__device__ __forceinline__ bf16_t f2bf(float f) { unsigned u = __float_as_uint(f); return (bf16_t)((u + 0x7fffu + ((u >> 16) & 1u)) >> 16); }

#if HYBRID
__global__ void __launch_bounds__(64) attn_a_naive(const bf16_t* Q, const bf16_t* Kb, const bf16_t* Vb, const bf16_t* G, const int* pos, const float* relb, bf16_t* OG) {
    int gid = blockIdx.x * 64 + threadIdx.x;
    int q = gid & (SEQ - 1), h = (gid >> 11) & 15, b = gid >> 15;
    int c = q >> 6;
    size_t trow = (size_t)b * SEQ + q;
    float qv[64];
#pragma unroll
    for (int d = 0; d < 64; ++d) qv[d] = bf2f(Q[trow * DM + h * 64 + d]);
    int qpos = pos[trow];
    const float* rb = relb + h * NREL;
    int kstart = (c - PAST) * CHUNK; if (kstart < 0) kstart = 0;
    int kend = (c + 1) * CHUNK;
    float m = -1e30f, l = 0.f;
    for (int k = kstart; k < kend; ++k) {
        size_t krow = (size_t)b * SEQ + k;
        const uint4* kp = (const uint4*)(Kb + krow * DM + h * 64);
        float s = 0.f;
#pragma unroll
        for (int j = 0; j < 8; ++j) { uint4 w = kp[j]; unsigned ww[4] = {w.x, w.y, w.z, w.w};
#pragma unroll
            for (int e = 0; e < 4; ++e) { s += qv[j * 8 + 2 * e] * __uint_as_float(ww[e] << 16) + qv[j * 8 + 2 * e + 1] * __uint_as_float(ww[e] & 0xffff0000u); } }
        int rel = qpos - pos[krow]; rel = rel < -MAXREL ? -MAXREL : (rel > MAXREL ? MAXREL : rel);
        s = s + rb[rel + MAXREL] * LOG2E;
        float mn = fmaxf(m, s);
        l = l * exp2f(m - mn) + exp2f(s - mn); m = mn;
    }
    float o[64];
#pragma unroll
    for (int d = 0; d < 64; ++d) o[d] = 0.f;
    float il = 1.f / l;
    for (int k = kstart; k < kend; ++k) {
        size_t krow = (size_t)b * SEQ + k;
        const uint4* kp = (const uint4*)(Kb + krow * DM + h * 64);
        float s = 0.f;
#pragma unroll
        for (int j = 0; j < 8; ++j) { uint4 w = kp[j]; unsigned ww[4] = {w.x, w.y, w.z, w.w};
#pragma unroll
            for (int e = 0; e < 4; ++e) { s += qv[j * 8 + 2 * e] * __uint_as_float(ww[e] << 16) + qv[j * 8 + 2 * e + 1] * __uint_as_float(ww[e] & 0xffff0000u); } }
        int rel = qpos - pos[krow]; rel = rel < -MAXREL ? -MAXREL : (rel > MAXREL ? MAXREL : rel);
        s = s + rb[rel + MAXREL] * LOG2E;
        float p = exp2f(s - m) * il;
        const uint4* vp = (const uint4*)(Vb + krow * DM + h * 64);
#pragma unroll
        for (int j = 0; j < 8; ++j) { uint4 w = vp[j]; unsigned ww[4] = {w.x, w.y, w.z, w.w};
#pragma unroll
            for (int e = 0; e < 4; ++e) { o[j * 8 + 2 * e] += p * __uint_as_float(ww[e] << 16); o[j * 8 + 2 * e + 1] += p * __uint_as_float(ww[e] & 0xffff0000u); } }
    }
#pragma unroll
    for (int d = 0; d < 64; ++d) {
        float g = bf2f(G[trow * DM + h * 64 + d]);
        float sg = g / (1.f + __expf(-g));
        OG[trow * DM + h * 64 + d] = f2bf(o[d] * sg);
    }
}

__global__ void __launch_bounds__(64) attn_b_naive(const bf16_t* Q, const bf16_t* Kb, const bf16_t* Vb, const bf16_t* G,
                                                   const float* lq1, const float* lk1, const float* lq2, const float* lk2, const float* subln, bf16_t* OG) {
    int gid = blockIdx.x * 64 + threadIdx.x;
    int m = gid & 1, rowid = gid >> 1;
    int q = rowid & (SEQ - 1), h = (rowid >> 11) & 7, b = rowid >> 14;
    float d1 = 0.f, d2 = 0.f;
    for (int i = 0; i < 64; ++i) { d1 += lq1[i] * lk1[i]; d2 += lq2[i] * lk2[i]; }
    float lam = __expf(d1) - __expf(d2) + LAM_INIT;
    size_t trow = (size_t)b * SEQ + q;
    float qv[64];
#pragma unroll
    for (int d = 0; d < 64; ++d) qv[d] = bf2f(Q[trow * DM + h * 128 + m * 64 + d]);
    int kend = ((q >> 6) + 1) * CHUNK;
    float mx = -1e30f, l = 0.f;
    for (int k = 0; k < kend; ++k) {
        size_t krow = (size_t)b * SEQ + k;
        const uint4* kp = (const uint4*)(Kb + krow * DM + h * 128 + m * 64);
        float s = 0.f;
#pragma unroll
        for (int j = 0; j < 8; ++j) { uint4 w = kp[j]; unsigned ww[4] = {w.x, w.y, w.z, w.w};
#pragma unroll
            for (int e = 0; e < 4; ++e) { s += qv[j * 8 + 2 * e] * __uint_as_float(ww[e] << 16) + qv[j * 8 + 2 * e + 1] * __uint_as_float(ww[e] & 0xffff0000u); } }
        float mn = fmaxf(mx, s);
        l = l * exp2f(mx - mn) + exp2f(s - mn); mx = mn;
    }
    float o[64];
#pragma unroll
    for (int d = 0; d < 64; ++d) o[d] = 0.f;
    float il = 1.f / l;
    for (int k = 0; k < kend; ++k) {
        size_t krow = (size_t)b * SEQ + k;
        const uint4* kp = (const uint4*)(Kb + krow * DM + h * 128 + m * 64);
        float s = 0.f;
#pragma unroll
        for (int j = 0; j < 8; ++j) { uint4 w = kp[j]; unsigned ww[4] = {w.x, w.y, w.z, w.w};
#pragma unroll
            for (int e = 0; e < 4; ++e) { s += qv[j * 8 + 2 * e] * __uint_as_float(ww[e] << 16) + qv[j * 8 + 2 * e + 1] * __uint_as_float(ww[e] & 0xffff0000u); } }
        float p = exp2f(s - mx) * il;
        float po = __shfl_xor(p, 1);
        float p0 = m ? po : p, p1 = m ? p : po;
        float a = p0 - lam * p1;
        const uint4* vp = (const uint4*)(Vb + krow * DM + h * 128 + m * 64);
#pragma unroll
        for (int j = 0; j < 8; ++j) { uint4 w = vp[j]; unsigned ww[4] = {w.x, w.y, w.z, w.w};
#pragma unroll
            for (int e = 0; e < 4; ++e) { o[j * 8 + 2 * e] += a * __uint_as_float(ww[e] << 16); o[j * 8 + 2 * e + 1] += a * __uint_as_float(ww[e] & 0xffff0000u); } }
    }
    float ss = 0.f;
#pragma unroll
    for (int d = 0; d < 64; ++d) ss += o[d] * o[d];
    ss += __shfl_xor(ss, 1);
    float r = rsqrtf(ss * (1.f / 128.f) + EPS) * (1.f - LAM_INIT);
#pragma unroll
    for (int d = 0; d < 64; ++d) {
        int c = h * 128 + m * 64 + d;
        float g = bf2f(G[trow * DM + c]);
        float sg = g / (1.f + __expf(-g));
        OG[trow * DM + c] = f2bf(o[d] * r * subln[m * 64 + d] * sg);
    }
}
#endif
namespace pg8 {
#define PG8_LAS __attribute__((address_space(3)))
typedef unsigned short bf16_t;
typedef short bf16x8 __attribute__((ext_vector_type(8)));
typedef float f32x4 __attribute__((ext_vector_type(4)));
typedef unsigned u32x4 __attribute__((ext_vector_type(4)));
constexpr int BM = 256, BK = 64, HALF = 128, HTB = HALF * BK * 2  , STAGE_BYTES = 8 * HTB, NXCD = 8, WGM = 8;

__host__ __device__ __forceinline__ int lds_byte(int r, int c) { const int st = (r >> 4) * 2 + (c >> 5), rr = r & 15, cc = c & 31, ob = rr * 64 + cc * 2; return st * 1024 + (ob ^ (((ob >> 9) & 1) << 5)); }
__host__ __device__ __forceinline__ void stage_rc(int b, int& R, int& C) { const int st = b / 1024, sb = b % 1024, swz = sb ^ (((sb >> 9) & 1) << 5); R = (st >> 1) * 16 + swz / 64; C = (st & 1) * 32 + (swz % 64) / 2; }
__host__ __device__ __forceinline__ int perm32(int rho) { const int n = rho >> 4, i = rho & 15; return 8 * (i >> 2) + 4 * n + (i & 3); }

struct Unit { int pm, pn; };
struct Gemm { const bf16_t* A; const bf16_t* Bt; int M, N, K; };

struct StaticOrder {
    int nM, nN, nwg, G, c;
    __host__ __device__ void init(int M, int N, int G_, int c_) { nM = M / BM; nN = N / BM; nwg = nM * nN; G = G_; c = c_; }
    __host__ __device__ bool next(int i, Unit& u) const {
        const long L = (long)i * G + c; if (L >= nwg) return false;
        int wgid = (int)L; { const int q = nwg / NXCD, r = nwg % NXCD, xcd = wgid % NXCD, off = wgid / NXCD; wgid = (xcd < r ? xcd * (q + 1) : r * (q + 1) + (xcd - r) * q) + off; }
        const int nig = WGM * nN, gid = wgid / nig, fm = gid * WGM, gsz = (nM - fm) < WGM ? (nM - fm) : WGM;
        u.pm = fm + ((wgid % nig) % gsz); u.pn = (wgid % nig) / gsz; return true;
    }
    __device__ __forceinline__ void a_ready(const Unit&) const {}
    __device__ __forceinline__ void done(const Unit&) const {}
};

__device__ __forceinline__ unsigned cvt_pk_bf16(float lo, float hi) { unsigned r; asm volatile("v_cvt_pk_bf16_f32 %0, %1, %2" : "=v"(r) : "v"(lo), "v"(hi)); return r; }
struct EpiSplit {
    static constexpr bool PERM = true, AFTER_DRAIN = false;
    bf16_t* O; size_t split_stride; int scale_split; float scale; unsigned rope_mask; const float* cs;
    __device__ __forceinline__ void operator()(const f32x4 (&acc)[2][2][4][2], const Unit& u, int wr, int wc, int fr, int fq) const {
        const int row0 = u.pm * BM + wr * 64 + fr; int colt = u.pn * BM;
        const int t = colt >> 10; bf16_t* base = O + (size_t)t * split_stride; colt &= 1023;
        const float sc = (t == scale_split) ? scale : 1.f;
        const int col0 = colt + wc * 32 + 8 * fq;
        const bool rope = ((rope_mask >> t) & 1u) && !(wc & 1);
#pragma unroll
        for (int ai = 0; ai < 2; ++ai)
#pragma unroll
            for (int m = 0; m < 4; ++m) {
                const int row = row0 + ai * HALF + m * 16;
                bf16_t* rowp = base + (size_t)row * 1024 + col0;
                f32x4 c0 = {1.f, 1.f, 1.f, 1.f}, c1 = c0, s0 = {0.f, 0.f, 0.f, 0.f}, s1 = s0;
                if (rope) { const f32x4* cp = (const f32x4*)(cs + (size_t)row * 16); c0 = cp[0]; c1 = cp[1]; s0 = cp[2]; s1 = cp[3];
                    if (fq == 0) { s0 = -s0; s1 = -s1; } else if (fq >= 2) { c0 = (f32x4){1.f, 1.f, 1.f, 1.f}; c1 = c0; s0 = (f32x4){0.f, 0.f, 0.f, 0.f}; s1 = s0; } }
#pragma unroll
                for (int bj = 0; bj < 2; ++bj) { f32x4 v0 = acc[ai][bj][m][0], v1 = acc[ai][bj][m][1];
                    if (rope) { f32x4 p0, p1;
#pragma unroll
                        for (int e = 0; e < 4; ++e) { p0[e] = __shfl_xor(v0[e], 16); p1[e] = __shfl_xor(v1[e], 16); }
                        v0 = v0 * c0 + p0 * s0; v1 = v1 * c1 + p1 * s1; }
                    v0 = v0 * sc; v1 = v1 * sc; u32x4 w; w.x = cvt_pk_bf16(v0[0], v0[1]); w.y = cvt_pk_bf16(v0[2], v0[3]); w.z = cvt_pk_bf16(v1[0], v1[1]); w.w = cvt_pk_bf16(v1[2], v1[3]);
                    *(u32x4*)(rowp + bj * HALF) = w; } }
    }
};
struct EpiF32 {
    static constexpr bool PERM = false, AFTER_DRAIN = false;
    float* C; int ldc;
    __device__ __forceinline__ void operator()(const f32x4 (&acc)[2][2][4][2], const Unit& u, int wr, int wc, int fr, int fq) const {
        const int row0 = u.pm * BM + wr * 64 + fr, col0 = u.pn * BM + wc * 32 + 4 * fq;
#pragma unroll
        for (int ai = 0; ai < 2; ++ai)
#pragma unroll
            for (int m = 0; m < 4; ++m) { float* rowp = C + (size_t)(row0 + ai * HALF + m * 16) * ldc + col0;
#pragma unroll
                for (int bj = 0; bj < 2; ++bj)
#pragma unroll
                    for (int n = 0; n < 2; ++n) *(f32x4*)(rowp + bj * HALF + n * 16) = acc[ai][bj][m][n]; }
    }
};
template <class Epi, class Sched, bool ALIGN_EPI = false, bool SP2 = false>
__device__ __forceinline__ void gemm_phase(PG8_LAS unsigned char* lds, const Gemm g, const Sched& S, const Epi& E) {
    const int tid = threadIdx.x, wid = __builtin_amdgcn_readfirstlane(tid >> 6), lane = tid & 63, wr = wid >> 2, wc = wid & 3, fr = lane & 15, fq = lane >> 4;
    const int K = g.K, nt = K / BK;
    unsigned voffA[2], voffB[2];
#pragma unroll
    for (int i = 0; i < 2; ++i) { int R, C; stage_rc(tid * 16 + i * 8192, R, C); const int Rb = Epi::PERM ? ((R & ~31) + perm32(R & 31)) : R;
        voffA[i] = (unsigned)(R * K + C) * 2u; voffB[i] = (unsigned)(Rb * K + C) * 2u; }
    const size_t kstep = (size_t)(BK * 2);
    const size_t hstep = (size_t)HALF * K * 2;
    const size_t tstep = 2 * hstep;
    const unsigned ldsw = (unsigned)wid * 1024u;
    const int aoff = lds_byte(wr * 64 + fr, fq * 8), boff = lds_byte(wc * 32 + fr, fq * 8);
#define PG8_SA(b, h) (((b) * 2 + (h)) * HTB)
#define PG8_SB(b, h) ((4 + (b) * 2 + (h)) * HTB)
#define PG8_STAGE(bufoff, gbase, voff) do { _Pragma("unroll") for (int _i = 0; _i < 2; ++_i) \
        __builtin_amdgcn_global_load_lds((const unsigned*)((const char*)(gbase) + (voff)[_i]), (PG8_LAS unsigned*)(lds + (bufoff) + ldsw + _i * 8192), 16, 0, 0); } while (0)
#define PG8_LDA(dst, b, h) do { _Pragma("unroll") for (int m = 0; m < 4; ++m) _Pragma("unroll") for (int k = 0; k < 2; ++k) dst[m][k] = *(const PG8_LAS bf16x8*)(lds + PG8_SA(b, h) + aoff + m * 2048 + k * 1024); } while (0)
#define PG8_LDB(dst, b, h) do { _Pragma("unroll") for (int n = 0; n < 2; ++n) _Pragma("unroll") for (int k = 0; k < 2; ++k) dst[n][k] = *(const PG8_LAS bf16x8*)(lds + PG8_SB(b, h) + boff + n * 2048 + k * 1024); } while (0)
#define PG8_MMA(ai, bj, At, Bt) do { __builtin_amdgcn_s_setprio(1); _Pragma("unroll") for (int m = 0; m < 4; ++m) _Pragma("unroll") for (int n = 0; n < 2; ++n) _Pragma("unroll") for (int k = 0; k < 2; ++k) \
        acc[ai][bj][m][n] = __builtin_amdgcn_mfma_f32_16x16x32_bf16(Bt[n][k], At[m][k], acc[ai][bj][m][n], 0, 0, 0); __builtin_amdgcn_s_setprio(0); } while (0)
#define PG8_WAIT_V(n) asm volatile("s_waitcnt vmcnt(" #n ")" ::: "memory")
#define PG8_WAIT_L(n) asm volatile("s_waitcnt lgkmcnt(" #n ")" ::: "memory")
#define PG8_BAR __builtin_amdgcn_s_barrier()
#define PG8_SCHED __builtin_amdgcn_sched_barrier(0)
    Unit cur, nxt; int ui = 0;
    if (!S.next(0, cur)) return;
    f32x4 acc[2][2][4][2];
#pragma unroll
    for (int a = 0; a < 2; ++a)
#pragma unroll
        for (int b = 0; b < 2; ++b)
#pragma unroll
            for (int m = 0; m < 4; ++m)
#pragma unroll
                for (int n = 0; n < 2; ++n) acc[a][b][m][n] = (f32x4){0.f, 0.f, 0.f, 0.f};
    bf16x8 At[4][2], B0[2][2], B1[2][2];
    const char* cA = (const char*)g.A + (size_t)cur.pm * tstep; const char* cB = (const char*)g.Bt + (size_t)cur.pn * tstep;
    S.a_ready(cur);
    if constexpr (SP2) {
        PG8_STAGE(PG8_SB(0, 0), cB, voffB); PG8_STAGE(PG8_SB(0, 1), cB + hstep, voffB); PG8_STAGE(PG8_SA(0, 0), cA, voffA); PG8_STAGE(PG8_SA(0, 1), cA + hstep, voffA);
        if (wr == 1) PG8_BAR;
        PG8_WAIT_V(2); PG8_BAR;
        PG8_STAGE(PG8_SB(1, 0), cB + kstep, voffB); PG8_STAGE(PG8_SA(1, 0), cA + kstep, voffA); PG8_STAGE(PG8_SB(1, 1), cB + hstep + kstep, voffB);
        PG8_WAIT_V(6); PG8_BAR;
    } else {
        PG8_STAGE(PG8_SB(0, 0), cB, voffB); PG8_STAGE(PG8_SA(0, 0), cA, voffA); PG8_STAGE(PG8_SB(0, 1), cB + hstep, voffB); PG8_STAGE(PG8_SA(0, 1), cA + hstep, voffA);
        if (wr == 1) PG8_BAR;
        PG8_WAIT_V(4); PG8_BAR;
        PG8_STAGE(PG8_SB(1, 0), cB + kstep, voffB); PG8_STAGE(PG8_SA(1, 0), cA + kstep, voffA); PG8_STAGE(PG8_SB(1, 1), cB + hstep + kstep, voffB);
        PG8_WAIT_V(6); PG8_BAR;
    }
    for (;;) {
        const bool has_next = S.next(ui + 1, nxt);
        const char* nA = has_next ? (const char*)g.A + (size_t)nxt.pm * tstep : cA; const char* nB = has_next ? (const char*)g.Bt + (size_t)nxt.pn * tstep : cB;
        for (int t = 0; t < nt; t += 2) {
            const bool last = (t == nt - 2);
            const char* a1 = cA + (size_t)(t + 1) * kstep;
            const char* a2 = last ? nA : cA + (size_t)(t + 2) * kstep; const char* b2 = last ? nB : cB + (size_t)(t + 2) * kstep;
            const char* a3 = a2 + kstep; const char* b3 = b2 + kstep;
            if (last && has_next) S.a_ready(nxt);
            if constexpr (SP2) {
            PG8_LDB(B0, 0, 0); PG8_LDB(B1, 0, 1); PG8_SCHED; PG8_LDA(At, 0, 0); PG8_STAGE(PG8_SA(1, 1), a1 + hstep, voffA);
            PG8_WAIT_V(8); PG8_WAIT_L(0); PG8_BAR; PG8_MMA(0, 0, At, B0); PG8_MMA(0, 1, At, B1); PG8_BAR; PG8_SCHED;
            PG8_LDA(At, 0, 1); PG8_STAGE(PG8_SB(0, 0), b2, voffB); PG8_STAGE(PG8_SB(0, 1), b2 + hstep, voffB); PG8_STAGE(PG8_SA(0, 0), a2, voffA);
            PG8_WAIT_V(8); PG8_WAIT_L(0); PG8_BAR; PG8_MMA(1, 0, At, B0); PG8_MMA(1, 1, At, B1); PG8_BAR; PG8_SCHED;
            PG8_LDB(B0, 1, 0); PG8_LDB(B1, 1, 1); PG8_SCHED; PG8_LDA(At, 1, 0); PG8_STAGE(PG8_SA(0, 1), a2 + hstep, voffA);
            PG8_WAIT_V(8); PG8_WAIT_L(0); PG8_BAR; PG8_MMA(0, 0, At, B0); PG8_MMA(0, 1, At, B1); PG8_BAR; PG8_SCHED;
            PG8_LDA(At, 1, 1); PG8_STAGE(PG8_SB(1, 0), b3, voffB); PG8_STAGE(PG8_SB(1, 1), b3 + hstep, voffB); PG8_STAGE(PG8_SA(1, 0), a3, voffA);
            PG8_WAIT_V(8); PG8_WAIT_L(0); PG8_BAR; PG8_MMA(1, 0, At, B0); PG8_MMA(1, 1, At, B1); PG8_BAR; PG8_SCHED;
            } else {
            PG8_LDB(B0, 0, 0); PG8_SCHED; PG8_LDA(At, 0, 0); PG8_STAGE(PG8_SA(1, 1), a1 + hstep, voffA);
            PG8_WAIT_L(8); PG8_BAR; PG8_WAIT_L(0); PG8_MMA(0, 0, At, B0); PG8_BAR; PG8_SCHED;
            PG8_LDB(B1, 0, 1); PG8_STAGE(PG8_SB(0, 0), b2, voffB);
            PG8_BAR; PG8_WAIT_L(0); PG8_MMA(0, 1, At, B1); PG8_BAR;
            PG8_LDA(At, 0, 1); PG8_STAGE(PG8_SA(0, 0), a2, voffA);
            PG8_BAR; PG8_WAIT_L(0); PG8_MMA(1, 0, At, B0); PG8_BAR; PG8_SCHED;
            PG8_STAGE(PG8_SB(0, 1), b2 + hstep, voffB);
            PG8_WAIT_V(6); PG8_BAR; PG8_MMA(1, 1, At, B1); PG8_BAR;
            PG8_LDB(B0, 1, 0); PG8_SCHED; PG8_LDA(At, 1, 0); PG8_STAGE(PG8_SA(0, 1), a2 + hstep, voffA);
            PG8_WAIT_L(8); PG8_BAR; PG8_WAIT_L(0); PG8_MMA(0, 0, At, B0); PG8_BAR; PG8_SCHED;
            PG8_LDB(B1, 1, 1); PG8_STAGE(PG8_SB(1, 0), b3, voffB);
            PG8_BAR; PG8_WAIT_L(0); PG8_MMA(0, 1, At, B1); PG8_BAR;
            PG8_LDA(At, 1, 1); PG8_STAGE(PG8_SA(1, 0), a3, voffA);
            PG8_BAR; PG8_WAIT_L(0); PG8_MMA(1, 0, At, B0); PG8_BAR; PG8_SCHED;
            PG8_STAGE(PG8_SB(1, 1), b3 + hstep, voffB);
            PG8_WAIT_V(6); PG8_BAR; PG8_MMA(1, 1, At, B1); PG8_BAR;
            }
        }
        if constexpr (ALIGN_EPI) { if (wr == 0) PG8_BAR; }
        if constexpr (!Epi::AFTER_DRAIN) { E(acc, cur, wr, wc, fr, fq); S.done(cur); }
        if (!has_next) break;
#pragma unroll
        for (int a = 0; a < 2; ++a)
#pragma unroll
            for (int b = 0; b < 2; ++b)
#pragma unroll
                for (int m = 0; m < 4; ++m)
#pragma unroll
                    for (int n = 0; n < 2; ++n) acc[a][b][m][n] = (f32x4){0.f, 0.f, 0.f, 0.f};
        cur = nxt; cA = nA; cB = nB; ++ui;
        if constexpr (ALIGN_EPI) { if (wr == 1) PG8_BAR; }
    }
    PG8_WAIT_V(0);
    if constexpr (!ALIGN_EPI) { if (wr == 0) PG8_BAR; }
    PG8_BAR;
    if constexpr (Epi::AFTER_DRAIN) { E.fused(acc, cur, wr, wc, fr, fq, lds, wid, lane); S.done(cur); }
#undef PG8_SA
#undef PG8_SB
#undef PG8_STAGE
#undef PG8_LDA
#undef PG8_LDB
#undef PG8_MMA
#undef PG8_WAIT_V
#undef PG8_WAIT_L
#undef PG8_BAR
#undef PG8_SCHED
}
}
namespace att {
#define ATT_LAS __attribute__((address_space(3)))
typedef ATT_LAS unsigned char lds_u8;
typedef const ATT_LAS unsigned char* lds_cptr;
using bf16x8 = __attribute__((ext_vector_type(8))) short;
using s16x4 = __attribute__((ext_vector_type(4))) short;
using f32x16 = __attribute__((ext_vector_type(16))) float;
using u32x4 = __attribute__((ext_vector_type(4))) unsigned;
using f32x4 = __attribute__((ext_vector_type(4))) float;
typedef float f32x2_t __attribute__((ext_vector_type(2))); typedef __bf16 bf16x2_t __attribute__((ext_vector_type(2)));
__device__ __forceinline__ int crow(int r, int hi) { return (r & 3) + 8 * (r >> 2) + 4 * hi; }
#define ATT_SBAR() __builtin_amdgcn_sched_barrier(0)
#define ATT_WAIT_BAR(N) asm volatile("s_waitcnt vmcnt(" #N ") lgkmcnt(0)\n\ts_barrier" ::: "memory")
__device__ __forceinline__ void glds16(const void* gsrc, unsigned lds_dst) { unsigned keep;
    asm volatile("s_mov_b32 %0, m0\n\ts_mov_b32 m0, %2\n\ts_nop 0\n\tglobal_load_lds_dwordx4 %1, off\n\ts_mov_b32 m0, %0" : "=&s"(keep) : "v"(gsrc), "s"(lds_dst) : "memory"); }
__device__ __forceinline__ unsigned cvtpk(float lo, float hi) { f32x2_t v = {lo, hi}; bf16x2_t b = __builtin_convertvector(v, bf16x2_t); return __builtin_bit_cast(unsigned, b); }
__device__ __forceinline__ float silu(float g) { return g * __builtin_amdgcn_rcpf(1.f + __builtin_amdgcn_exp2f(-g * LOG2E)); }

__device__ __forceinline__ void qkt(f32x16& p0, f32x16& p1, lds_cptr kslot, const bf16x8* qr, int r32, int hi) {
    lds_cptr kb = kslot + hi * 1024 + r32 * 16;
    const f32x16 z = {};
#pragma unroll
    for (int d0 = 0; d0 < 4; ++d0) {
        const bf16x8 b0 = *(const ATT_LAS bf16x8*)(kb + d0 * 2048);
        const bf16x8 b1 = *(const ATT_LAS bf16x8*)(kb + d0 * 2048 + 512);
        if (d0 == 0) { p0 = __builtin_amdgcn_mfma_f32_32x32x16_bf16(b0, qr[0], z, 0, 0, 0); p1 = __builtin_amdgcn_mfma_f32_32x32x16_bf16(b1, qr[0], z, 0, 0, 0); }
        else { p0 = __builtin_amdgcn_mfma_f32_32x32x16_bf16(b0, qr[d0], p0, 0, 0, 0); p1 = __builtin_amdgcn_mfma_f32_32x32x16_bf16(b1, qr[d0], p1, 0, 0, 0); }
    }
}
__device__ __forceinline__ float rowmax(const f32x16& p0, const f32x16& p1) {
    float a = fmaxf(p0[0], p1[0]);
#pragma unroll
    for (int r = 1; r < 16; ++r) a = fmaxf(a, fmaxf(p0[r], p1[r]));
    auto rr = __builtin_amdgcn_permlane32_swap(__float_as_uint(a), __float_as_uint(a), false, false);
    return fmaxf(__uint_as_float(rr[0]), __uint_as_float(rr[1]));
}
template <int NDV> __device__ __forceinline__ void pv(f32x16* o, int vb, bf16x8 pa0, bf16x8 pa1, bf16x8 pa2, bf16x8 pa3) {
#pragma unroll
    for (int d0 = 0; d0 < NDV; ++d0) { s16x4 lo[4], hi[4];
#pragma unroll
        for (int ks = 0; ks < 4; ++ks) {
            asm volatile("ds_read_b64_tr_b16 %0,%1 offset:%c2" : "=&v"(lo[ks]) : "v"(vb), "i"(d0 * 4096 + ks * 1024) : "memory");
            asm volatile("ds_read_b64_tr_b16 %0,%1 offset:%c2" : "=&v"(hi[ks]) : "v"(vb), "i"(d0 * 4096 + ks * 1024 + 512) : "memory"); }
        asm volatile("s_waitcnt lgkmcnt(0)" ::: "memory"); ATT_SBAR();
#define ATT_PK(k) (bf16x8){lo[k][0], lo[k][1], lo[k][2], lo[k][3], hi[k][0], hi[k][1], hi[k][2], hi[k][3]}
        o[d0] = __builtin_amdgcn_mfma_f32_32x32x16_bf16(pa0, ATT_PK(0), o[d0], 0, 0, 0);
        o[d0] = __builtin_amdgcn_mfma_f32_32x32x16_bf16(pa1, ATT_PK(1), o[d0], 0, 0, 0);
        o[d0] = __builtin_amdgcn_mfma_f32_32x32x16_bf16(pa2, ATT_PK(2), o[d0], 0, 0, 0);
        o[d0] = __builtin_amdgcn_mfma_f32_32x32x16_bf16(pa3, ATT_PK(3), o[d0], 0, 0, 0);
#undef ATT_PK
    }
}
template <int NDV> __device__ __forceinline__ void softmax_step(f32x16& p0, f32x16& p1, float& m, float& l, f32x16* o, ATT_LAS float* wsf, int r32, int hi, u32x4& pw0, u32x4& pw1, u32x4& pw2, u32x4& pw3) {
    const float rm = rowmax(p0, p1);
    const float mn = fmaxf(m, rm);
    if (__any(mn > m)) {
        const float alpha = __builtin_amdgcn_exp2f(m - mn);
        l *= alpha;
        if (hi == 0) wsf[r32] = alpha;
        asm volatile("s_waitcnt lgkmcnt(0)" ::: "memory");
        float al[16];
#pragma unroll
        for (int r = 0; r < 16; ++r) al[r] = wsf[crow(r, hi)];
#pragma unroll
        for (int d = 0; d < NDV; ++d)
#pragma unroll
            for (int r = 0; r < 16; ++r) o[d][r] *= al[r];
        m = mn;
    }
    float s = 0.f;
#pragma unroll
    for (int r = 0; r < 16; ++r) { p0[r] = __builtin_amdgcn_exp2f(p0[r] - m); p1[r] = __builtin_amdgcn_exp2f(p1[r] - m); s += p0[r] + p1[r]; }
    l += s;
    pw0 = (u32x4){cvtpk(p0[0], p0[1]), cvtpk(p0[2], p0[3]), cvtpk(p0[4], p0[5]), cvtpk(p0[6], p0[7])};
    pw1 = (u32x4){cvtpk(p0[8], p0[9]), cvtpk(p0[10], p0[11]), cvtpk(p0[12], p0[13]), cvtpk(p0[14], p0[15])};
    pw2 = (u32x4){cvtpk(p1[0], p1[1]), cvtpk(p1[2], p1[3]), cvtpk(p1[4], p1[5]), cvtpk(p1[6], p1[7])};
    pw3 = (u32x4){cvtpk(p1[8], p1[9]), cvtpk(p1[10], p1[11]), cvtpk(p1[12], p1[13]), cvtpk(p1[14], p1[15])};
}

constexpr int A_K = 0, A_V = 16384, A_WS = 32768, A_OST = A_WS + 2048, A_BIAS = A_OST + 32768, A_POSK = A_BIAS + 1280, A_TMAX = A_POSK + 3072, A_TMIN = A_TMAX + 64, A_BYTES = A_TMIN + 64;
__device__ __forceinline__ void attn_a_unit(int b, int h, int u, const bf16_t* Q, const bf16_t* K, const bf16_t* V, const bf16_t* G, bf16_t* O, const int* pos, const float* relb, lds_u8* shm) {
    const int tid = threadIdx.x, lane = tid & 63, r32 = lane & 31, hi = lane >> 5; const int wid = __builtin_amdgcn_readfirstlane(tid >> 6);
    const long rowbase = (long)b * SEQ; const int q0 = u * 256;
    const int c0 = 4 * u, kc_lo = (c0 - PAST) > 0 ? (c0 - PAST) : 0, NT = c0 + 3 - kc_lo + 1;
    const int cw = c0 + (wid >> 1); const int t_lo = ((cw - PAST) > 0 ? (cw - PAST) : 0) - kc_lo, t_hi = cw - kc_lo;
    ATT_LAS float* wsf = (ATT_LAS float*)(shm + A_WS) + wid * 64;
    ATT_LAS float* bias2 = (ATT_LAS float*)(shm + A_BIAS);
    ATT_LAS int* posk = (ATT_LAS int*)(shm + A_POSK);
    ATT_LAS int* tmax = (ATT_LAS int*)(shm + A_TMAX); ATT_LAS int* tmin = (ATT_LAS int*)(shm + A_TMIN);
    const unsigned lds0 = (unsigned)(uintptr_t)shm;
    const bf16_t* Kh = K + (rowbase + (long)kc_lo * 64) * DM + h * 64; const bf16_t* Vh = V + (rowbase + (long)kc_lo * 64) * DM + h * 64;
    const bf16_t* ksrc = Kh + (long)lane * DM + wid * 8;
    const bf16_t* vsrc = Vh + (long)(16 * (wid & 3) + (lane >> 2)) * DM + (wid >> 2) * 32 + (lane & 3) * 8;
    const unsigned kdst = lds0 + A_K + wid * 1024, vdst = lds0 + A_V + wid * 1024;
#define A_DMA(t, slot) do { glds16(ksrc + (long)(t) * 64 * DM, (unsigned)__builtin_amdgcn_readfirstlane(kdst + (slot) * 8192)); glds16(vsrc + (long)(t) * 64 * DM, (unsigned)__builtin_amdgcn_readfirstlane(vdst + (slot) * 8192)); } while (0)
    A_DMA(0, 0);
    if (tid < NREL) bias2[tid] = relb[h * NREL + tid] * LOG2E;
    for (int i = tid; i < NT * 64; i += 512) posk[i] = pos[rowbase + kc_lo * 64 + i];
    asm volatile("s_waitcnt lgkmcnt(0)\n\ts_barrier" ::: "memory");
    for (int t = wid; t < NT; t += 8) { int v = posk[t * 64 + lane]; int mx = v, mn = v;
#pragma unroll
        for (int o_ = 1; o_ < 64; o_ <<= 1) { mx = max(mx, __shfl_xor(mx, o_)); mn = min(mn, __shfl_xor(mn, o_)); }
        if (lane == 0) { tmax[t] = mx; tmin[t] = mn; } }
    const bf16_t* Qw = Q + (rowbase + q0 + wid * 32) * DM + h * 64;
    bf16x8 qr[4];
#pragma unroll
    for (int d0 = 0; d0 < 4; ++d0) qr[d0] = *reinterpret_cast<const bf16x8*>(&Qw[(long)r32 * DM + d0 * 16 + hi * 8]);
    const int qpos = pos[rowbase + q0 + wid * 32 + r32];
    float m = -1e30f, l = 0.f; f32x16 o[2]; o[0] = f32x16{}; o[1] = f32x16{};
    const int vb0 = (int)(lds0 + A_V) + ((lane >> 4) & 1) * 32 + (lane & 3) * 8 + (4 * hi + ((lane & 15) >> 2)) * 64;
    for (int t = 0; t < NT; ++t) {
        ATT_WAIT_BAR(0);
        if (t + 1 < NT) A_DMA(t + 1, (t + 1) & 1);
        if (t >= t_lo && t <= t_hi) {
            const int slot = t & 1;
            f32x16 p0, p1; u32x4 pw0, pw1, pw2, pw3;
            qkt(p0, p1, (lds_cptr)(shm + A_K + slot * 8192), qr, r32, hi);
            const int kmx = tmax[t], kmn = tmin[t];
            if (__all(qpos - kmx >= MAXREL)) { const float bb = bias2[2 * MAXREL];
#pragma unroll
                for (int r = 0; r < 16; ++r) { p0[r] += bb; p1[r] += bb; } }
            else if (__all(qpos - kmn <= -MAXREL)) { const float bb = bias2[0];
#pragma unroll
                for (int r = 0; r < 16; ++r) { p0[r] += bb; p1[r] += bb; } }
            else {
#pragma unroll
                for (int r = 0; r < 16; ++r) { const int kk = t * 64 + crow(r, hi);
                    int r0 = qpos - posk[kk], r1 = qpos - posk[kk + 32];
                    r0 = min(max(r0, -MAXREL), MAXREL) + MAXREL; r1 = min(max(r1, -MAXREL), MAXREL) + MAXREL;
                    p0[r] += bias2[r0]; p1[r] += bias2[r1]; } }
            softmax_step<2>(p0, p1, m, l, o, wsf, r32, hi, pw0, pw1, pw2, pw3);
            ATT_SBAR();
            pv<2>(o, vb0 + slot * 8192, __builtin_bit_cast(bf16x8, pw0), __builtin_bit_cast(bf16x8, pw1), __builtin_bit_cast(bf16x8, pw2), __builtin_bit_cast(bf16x8, pw3));
        }
    }
#undef A_DMA
    { auto rr = __builtin_amdgcn_permlane32_swap(__float_as_uint(l), __float_as_uint(l), false, false); l = __uint_as_float(rr[0]) + __uint_as_float(rr[1]); }
    if (hi == 0) wsf[32 + r32] = l; asm volatile("s_waitcnt lgkmcnt(0)" ::: "memory");
    float rli[16];
#pragma unroll
    for (int r = 0; r < 16; ++r) rli[r] = __builtin_amdgcn_rcpf(wsf[32 + crow(r, hi)]);
    { ATT_LAS bf16_t* stg = (ATT_LAS bf16_t*)(shm + A_OST) + wid * 2048;
#pragma unroll
        for (int r = 0; r < 16; ++r) { const int orow = crow(r, hi);
#pragma unroll
            for (int d0 = 0; d0 < 2; ++d0) stg[orow * 64 + d0 * 32 + r32] = f2bf(o[d0][r] * rli[r]); }
        asm volatile("s_waitcnt lgkmcnt(0)" ::: "memory");
        const long orow0 = rowbase + q0 + wid * 32;
#pragma unroll
        for (int i = 0; i < 4; ++i) { const int row = i * 8 + (lane >> 3), ch = lane & 7;
            const u32x4 v = *(const ATT_LAS u32x4*)(stg + row * 64 + ch * 8);
            const u32x4 g = *(const u32x4*)(G + (orow0 + row) * DM + h * 64 + ch * 8);
            u32x4 w;
#pragma unroll
            for (int e = 0; e < 4; ++e) { const float v0 = __uint_as_float(v[e] << 16), v1 = __uint_as_float(v[e] & 0xffff0000u), g0 = __uint_as_float(g[e] << 16), g1 = __uint_as_float(g[e] & 0xffff0000u);
                w[e] = cvtpk(v0 * silu(g0), v1 * silu(g1)); }
            *(u32x4*)(O + (orow0 + row) * DM + h * 64 + ch * 8) = w; } }
    asm volatile("s_waitcnt lgkmcnt(0)\n\ts_barrier" ::: "memory");
}

constexpr int B_RING = 0, B_SLOT = 32768, B_WS = 65536, B_OST = B_WS + 2048, B_BYTES = B_OST + 32768;
__device__ __forceinline__ void attn_b_unit(int b, int h, int qb, const bf16_t* Q, const bf16_t* K, const bf16_t* V, const bf16_t* G, bf16_t* O, const float* subln, float lam, lds_u8* shm) {
    const int tid = threadIdx.x, lane = tid & 63, r32 = lane & 31, hi = lane >> 5; const int wid = __builtin_amdgcn_readfirstlane(tid >> 6);
    const int map = wid >> 2, wq = wid & 3;
    const long rowbase = (long)b * SEQ; const int q0 = qb * 128;
    const int NT = 2 * qb + 2; const int t_hi = 2 * qb + (wq >> 1);
    ATT_LAS float* wsf = (ATT_LAS float*)(shm + B_WS) + wid * 64;
    const unsigned lds0 = (unsigned)(uintptr_t)shm;
    const bf16_t* Kh = K + rowbase * DM + h * 128; const bf16_t* Vh = V + rowbase * DM + h * 128;
    const bf16_t* k0src = Kh + (long)lane * DM + wid * 8;
    const bf16_t* k1src = k0src + 64;
    const bf16_t* v0src = Vh + (long)(16 * (wid & 3) + (lane >> 2)) * DM + (wid >> 2) * 32 + (lane & 3) * 8;
    const bf16_t* v1src = v0src + 64;
    const unsigned k0dst = lds0 + B_RING + wid * 1024, k1dst = k0dst + 8192, v0dst = lds0 + B_RING + 16384 + wid * 1024, v1dst = v0dst + 8192;
#define B_DMA(t, slot) do { const long go_ = (long)(t) * 64 * DM; const unsigned so_ = (slot) * B_SLOT; \
        glds16(k0src + go_, (unsigned)__builtin_amdgcn_readfirstlane(k0dst + so_)); glds16(k1src + go_, (unsigned)__builtin_amdgcn_readfirstlane(k1dst + so_)); \
        glds16(v0src + go_, (unsigned)__builtin_amdgcn_readfirstlane(v0dst + so_)); glds16(v1src + go_, (unsigned)__builtin_amdgcn_readfirstlane(v1dst + so_)); } while (0)
    B_DMA(0, 0);
    const bf16_t* Qw = Q + (rowbase + q0 + wq * 32) * DM + h * 128 + map * 64;
    bf16x8 qr[4];
#pragma unroll
    for (int d0 = 0; d0 < 4; ++d0) qr[d0] = *reinterpret_cast<const bf16x8*>(&Qw[(long)r32 * DM + d0 * 16 + hi * 8]);
    float m = -1e30f, l = 0.f; f32x16 o[4];
#pragma unroll
    for (int d = 0; d < 4; ++d) o[d] = f32x16{};
    const int vb0 = (int)(lds0 + B_RING + 16384) + ((lane >> 4) & 1) * 32 + (lane & 3) * 8 + (4 * hi + ((lane & 15) >> 2)) * 64;
    for (int t = 0; t < NT; ++t) {
        ATT_WAIT_BAR(0);
        if (t + 1 < NT) B_DMA(t + 1, (t + 1) & 1);
        if (t <= t_hi) {
            const int slot = t & 1;
            f32x16 p0, p1; u32x4 pw0, pw1, pw2, pw3;
            qkt(p0, p1, (lds_cptr)(shm + B_RING + slot * B_SLOT + map * 8192), qr, r32, hi);
            softmax_step<4>(p0, p1, m, l, o, wsf, r32, hi, pw0, pw1, pw2, pw3);
            ATT_SBAR();
            pv<4>(o, vb0 + slot * B_SLOT, __builtin_bit_cast(bf16x8, pw0), __builtin_bit_cast(bf16x8, pw1), __builtin_bit_cast(bf16x8, pw2), __builtin_bit_cast(bf16x8, pw3));
        }
    }
#undef B_DMA
    { auto rr = __builtin_amdgcn_permlane32_swap(__float_as_uint(l), __float_as_uint(l), false, false); l = __uint_as_float(rr[0]) + __uint_as_float(rr[1]); }
    if (hi == 0) wsf[32 + r32] = l; asm volatile("s_waitcnt lgkmcnt(0)" ::: "memory");
    float rli[16];
#pragma unroll
    for (int r = 0; r < 16; ++r) rli[r] = __builtin_amdgcn_rcpf(wsf[32 + crow(r, hi)]);
    asm volatile("s_waitcnt lgkmcnt(0)\n\ts_barrier" ::: "memory");
    ATT_LAS float* X = (ATT_LAS float*)(shm + B_RING) + wq * 4096;
    if (map == 1) {
#pragma unroll
        for (int d = 0; d < 4; ++d)
#pragma unroll
            for (int r = 0; r < 16; ++r) X[(d * 16 + r) * 64 + lane] = o[d][r] * rli[r] * lam;
    }
    asm volatile("s_waitcnt lgkmcnt(0)\n\ts_barrier" ::: "memory");
    if (map == 0) {
        float ss[16];
#pragma unroll
        for (int r = 0; r < 16; ++r) ss[r] = 0.f;
#pragma unroll
        for (int d = 0; d < 4; ++d)
#pragma unroll
            for (int r = 0; r < 16; ++r) { const float v = o[d][r] * rli[r] - X[(d * 16 + r) * 64 + lane]; o[d][r] = v; ss[r] += v * v; }
#pragma unroll
        for (int r = 0; r < 16; ++r) {
#pragma unroll
            for (int o_ = 1; o_ < 32; o_ <<= 1) ss[r] += __shfl_xor(ss[r], o_);
            ss[r] = rsqrtf(ss[r] * (1.f / 128.f) + EPS) * (1.f - LAM_INIT); }
        ATT_LAS bf16_t* stg = (ATT_LAS bf16_t*)(shm + B_OST) + wq * 4096;
#pragma unroll
        for (int r = 0; r < 16; ++r) { const int orow = crow(r, hi);
#pragma unroll
            for (int d = 0; d < 4; ++d) stg[orow * 128 + d * 32 + r32] = f2bf(o[d][r] * ss[r]); }
        asm volatile("s_waitcnt lgkmcnt(0)" ::: "memory");
        const long orow0 = rowbase + q0 + wq * 32;
#pragma unroll
        for (int i = 0; i < 8; ++i) { const int row = i * 4 + (lane >> 4), ch = lane & 15;
            const u32x4 v = *(const ATT_LAS u32x4*)(stg + row * 128 + ch * 8);
            const u32x4 g = *(const u32x4*)(G + (orow0 + row) * DM + h * 128 + ch * 8);
            const f32x4 sa = *(const f32x4*)(subln + ch * 8), sb = *(const f32x4*)(subln + ch * 8 + 4);
            const float sl[8] = {sa[0], sa[1], sa[2], sa[3], sb[0], sb[1], sb[2], sb[3]};
            u32x4 w;
#pragma unroll
            for (int e = 0; e < 4; ++e) { const float v0 = __uint_as_float(v[e] << 16), v1 = __uint_as_float(v[e] & 0xffff0000u), g0 = __uint_as_float(g[e] << 16), g1 = __uint_as_float(g[e] & 0xffff0000u);
                w[e] = cvtpk(v0 * sl[2 * e] * silu(g0), v1 * sl[2 * e + 1] * silu(g1)); }
            *(u32x4*)(O + (orow0 + row) * DM + h * 128 + ch * 8) = w; }
    }
    asm volatile("s_waitcnt lgkmcnt(0)\n\ts_barrier" ::: "memory");
}
#undef ATT_SBAR
#undef ATT_WAIT_BAR
}
constexpr int NWAVES = 8;
constexpr size_t MiB = 1u << 20;
constexpr size_t WS_CTL = 0, CTL_ZERO_BYTES = 1 * MiB;
constexpr size_t WS_WIN_A = 2 * MiB, WS_WOUT_A = 10 * MiB, WS_WCAT = 12 * MiB, WS_WOUT_B = 20 * MiB, WS_CS = 22 * MiB;
constexpr size_t WS_XN = 32 * MiB, WS_S0 = 96 * MiB, WS_S1 = 160 * MiB, WS_S2 = 224 * MiB, WS_S3 = 288 * MiB, WS_Y = 352 * MiB, WS_END = 480 * MiB;
constexpr size_t SPL = (size_t)T * DM;
constexpr int CW_TMO = 0, CW_CODE = 1, CW_BAR = 4096;
constexpr int N_BAR_REGIONS = 3;
constexpr int RING_OFF = 0, RING_BYTES = 131072;
constexpr int LDSCTL_OFF = RING_BYTES, MISC_OFF = LDSCTL_OFF + 320;
constexpr int LDS_BYTES = 147456;

#define GAS __attribute__((address_space(1)))
#define LAS __attribute__((address_space(3)))
typedef unsigned v4u __attribute__((ext_vector_type(4)));
typedef float f32x4 __attribute__((ext_vector_type(4)));
typedef short bf16x8 __attribute__((ext_vector_type(8)));
typedef GAS unsigned gu32;
#define RLX_AGENT __ATOMIC_RELAXED, __HIP_MEMORY_SCOPE_AGENT
#define LDS_WAIT() asm volatile("s_waitcnt lgkmcnt(0)" ::: "memory")
#define VM_WAIT() asm volatile("s_waitcnt vmcnt(0)" ::: "memory")
__device__ __forceinline__ unsigned pk2(float lo, float hi) { return (unsigned)f2bf(lo) | ((unsigned)f2bf(hi) << 16); }
__device__ __forceinline__ float wave_sum(float v) {
#pragma unroll
    for (int o = 1; o < 64; o <<= 1) v += __shfl_xor(v, o);
    return v;
}
#define XB_TMO      128
#define XB_XCNT(j)  (256  + 64 * (j))
#define XB_XSUB(j)  (1280 + 64 * (j))
#define XB_XGEN(j)  (2304 + 64 * (j))
#define XB_TOP      3328
#define XB_TOPGEN   3392
#define XCD_BAR_WORDS 3456
#define XB_SPIN_CAP (1u << 18)

__device__ __forceinline__ unsigned xb_ld(unsigned* p)              { return __hip_atomic_load(p, __ATOMIC_RELAXED, __HIP_MEMORY_SCOPE_AGENT); }
__device__ __forceinline__ unsigned xb_add(unsigned* p, unsigned v) { return __hip_atomic_fetch_add(p, v, __ATOMIC_RELAXED, __HIP_MEMORY_SCOPE_AGENT); }
__device__ __forceinline__ unsigned xb_xcc_id() { return (unsigned)__builtin_amdgcn_s_getreg((3 << 11) | 20) & 0xFu; }
#define XB_SPIN(cond, bar) do { unsigned _sp = 0; while (cond) { __builtin_amdgcn_s_sleep(1); \
    if ((++_sp & 255u) == 0u) { if (xb_ld(&(bar)[XB_TMO])) break; if (_sp > XB_SPIN_CAP) { atomicAdd(&(bar)[XB_TMO], 1u); break; } } } } while (0)

struct XcdBarrier {
    unsigned* bar; unsigned x;
    volatile LAS unsigned* st;
};

__device__ __forceinline__ XcdBarrier xcd_barrier_post(unsigned* bar, volatile LAS unsigned* st) {
    XcdBarrier b; b.bar = bar; b.x = xb_xcc_id(); b.st = st;
    if (threadIdx.x == 0) (void)xb_add(&bar[XB_XCNT(b.x)], 1u);
    return b;
}
__device__ __forceinline__ void xcd_barrier_complete(unsigned* bar, unsigned x, unsigned& nloc, unsigned& nx) {
    const unsigned G = gridDim.x * gridDim.y * gridDim.z;
    unsigned sum, cnt, mine, sp = 0u;
    for (;;) {
        sum = 0u; cnt = 0u; mine = 0u;
#pragma unroll
        for (unsigned j = 0; j < 16; ++j) { const unsigned c = xb_ld(&bar[XB_XCNT(j)]); sum += c; cnt += (c > 0u) ? 1u : 0u; mine = (j == x) ? c : mine; }
        if (sum == G) break;
        __builtin_amdgcn_s_sleep(1);
        if ((++sp & 255u) == 0u) { if (xb_ld(&bar[XB_TMO])) break; if (sp > XB_SPIN_CAP) { atomicAdd(&bar[XB_TMO], 1u); break; } }
    }
    nloc = mine > 0u ? mine : 1u; nx = cnt > 0u ? cnt : 1u;
}

__device__ __forceinline__ void xcd_barrier(const XcdBarrier& b) {
    asm volatile("s_waitcnt vmcnt(0)" ::: "memory");
    __syncthreads();
    if (threadIdx.x == 0) {
        unsigned* bar = b.bar;
        __builtin_amdgcn_s_waitcnt(0);
        unsigned nloc = b.st[0], nx = b.st[1];
        if (nloc == 0u) { xcd_barrier_complete(bar, b.x, nloc, nx); b.st[0] = nloc; b.st[1] = nx; }
        const unsigned old = xb_add(&bar[XB_XSUB(b.x)], 1u);
        const unsigned gen = old / nloc;
        if (old + 1u == (gen + 1u) * nloc) {
            __builtin_amdgcn_fence(__ATOMIC_RELEASE, "agent");
            asm volatile("s_waitcnt vmcnt(0)" ::: "memory");
            const unsigned og = xb_add(&bar[XB_TOP], 1u);
            const unsigned tg = og / nx;
            if (og + 1u == (tg + 1u) * nx) xb_add(&bar[XB_TOPGEN], 1u);
            else XB_SPIN(xb_ld(&bar[XB_TOPGEN]) == tg, bar);
            __builtin_amdgcn_fence(__ATOMIC_ACQUIRE, "agent");
            xb_add(&bar[XB_XGEN(b.x)], 1u);
            asm volatile("s_waitcnt vmcnt(0)" ::: "memory");
        } else {
            XB_SPIN(xb_ld(&bar[XB_XGEN(b.x)]) == gen, bar);
            __builtin_amdgcn_fence(__ATOMIC_ACQUIRE, "agent");
            asm volatile("s_waitcnt vmcnt(0)" ::: "memory");
        }
    }
    __syncthreads();
}
struct Frame {
    LAS unsigned char* lds;
    volatile LAS unsigned* MISC;
    gu32* ctl;
    int tid, lane, wave, vcu, G;
};

__device__ __forceinline__ void p0_transpose_item(const float* W, const float* g, int K, int N, bf16_t* WT, int row_off, LAS float* scr, int item, int lane) {
    const int nblk = N / 32, kb = item / nblk, nb = item % nblk, k0 = 64 * kb, n0 = 32 * nb;
#pragma unroll 8
    for (int i = 0; i < 32; ++i) { const int kk = 2 * i + (lane >> 5); const float gv = g ? g[k0 + kk] : 1.f; scr[kk * 33 + (lane & 31)] = W[(size_t)(k0 + kk) * N + n0 + (lane & 31)] * gv; }
    LDS_WAIT(); asm volatile("" ::: "memory");
    const int c = lane & 7;
#pragma unroll
    for (int j = 0; j < 4; ++j) { const int n = (lane >> 3) + 8 * j; const LAS float* s = scr + (8 * c) * 33 + n;
        v4u o; o.x = pk2(s[0 * 33], s[1 * 33]); o.y = pk2(s[2 * 33], s[3 * 33]); o.z = pk2(s[4 * 33], s[5 * 33]); o.w = pk2(s[6 * 33], s[7 * 33]);
        *(GAS v4u*)(WT + (size_t)(row_off + n0 + n) * K + k0 + 8 * c) = o; }
    LDS_WAIT(); asm volatile("" ::: "memory");
}
__device__ __forceinline__ void rms_row_to_bf16(int lane, const float* xrow, bf16_t* orow) {
    const GAS f32x4* xr = (const GAS f32x4*)xrow + lane;
    f32x4 v[4]; float s = 0.f;
#pragma unroll
    for (int j = 0; j < 4; ++j) { v[j] = xr[64 * j]; s += (v[j].x * v[j].x + v[j].y * v[j].y) + (v[j].z * v[j].z + v[j].w * v[j].w); }
    const float r = rsqrtf(wave_sum(s) * (1.f / DM) + EPS);
    GAS unsigned long long* o8 = (GAS unsigned long long*)orow + lane;
#pragma unroll
    for (int j = 0; j < 4; ++j) o8[64 * j] = (unsigned long long)pk2(v[j].x * r, v[j].y * r) | ((unsigned long long)pk2(v[j].z * r, v[j].w * r) << 32);
}
__device__ __forceinline__ void resnorm_row(int lane, const float* hin, const float* y, const float* g, float* hout, bf16_t* hn) {
    const GAS f32x4* yr = (const GAS f32x4*)y + lane; const GAS f32x4* hr = (const GAS f32x4*)hin + lane; const GAS f32x4* gr = (const GAS f32x4*)g + lane;
    f32x4 v[4], hv[4]; float s = 0.f;
#pragma unroll
    for (int j = 0; j < 4; ++j) { v[j] = yr[64 * j]; hv[j] = hr[64 * j]; s += (v[j].x * v[j].x + v[j].y * v[j].y) + (v[j].z * v[j].z + v[j].w * v[j].w); }
    const float r = rsqrtf(wave_sum(s) * (1.f / DM) + EPS);
    float s2 = 0.f;
    GAS f32x4* orow = (GAS f32x4*)hout + lane;
#pragma unroll
    for (int j = 0; j < 4; ++j) { v[j] = hv[j] + v[j] * r * gr[64 * j]; s2 += (v[j].x * v[j].x + v[j].y * v[j].y) + (v[j].z * v[j].z + v[j].w * v[j].w); orow[64 * j] = v[j]; }
    if (hn) {
        const float r2 = rsqrtf(wave_sum(s2) * (1.f / DM) + EPS);
        GAS unsigned long long* o8 = (GAS unsigned long long*)hn + lane;
#pragma unroll
        for (int j = 0; j < 4; ++j) o8[64 * j] = (unsigned long long)pk2(v[j].x * r2, v[j].y * r2) | ((unsigned long long)pk2(v[j].z * r2, v[j].w * r2) << 32);
    }
}

struct Args { const float* in[18]; float* out; unsigned char* ws; int ph_lo, ph_hi, li, pad; };

__global__ void __launch_bounds__(NWAVES * 64, 2) mega_fwd(Args args) {
    extern __shared__ __attribute__((aligned(16))) unsigned char lds[];
    Frame F;
    F.lds = (LAS unsigned char*)lds;
    F.MISC = (volatile LAS unsigned*)(F.lds + MISC_OFF);
    F.tid = threadIdx.x; F.lane = F.tid & 63; F.wave = __builtin_amdgcn_readfirstlane(F.tid >> 6);
    F.G = gridDim.x; { const int bx = blockIdx.x; F.vcu = (F.G % 8 == 0) ? (bx % 8) * (F.G / 8) + bx / 8 : bx; }
    unsigned char* ws = args.ws;
    F.ctl = (gu32*)(ws + WS_CTL);
    const float* x = args.in[0]; const int* pos = (const int*)args.in[1];
    const float* a_norm_pre = args.in[2]; const float* a_w_in = args.in[3]; const float* a_rel_bias = args.in[4];
    const float* a_w_out = args.in[5]; const float* a_norm_post = args.in[6]; const float* kv_norm = args.in[7];
    const float* kv_w = args.in[8]; const float* b_norm_pre = args.in[9]; const float* b_w_in = args.in[10];
    const float* lq1 = args.in[11]; const float* lk1 = args.in[12]; const float* lq2 = args.in[13]; const float* lk2 = args.in[14];
    const float* b_subln = args.in[15]; const float* b_w_out = args.in[16]; const float* b_norm_post = args.in[17];
    float* out = args.out;
    bf16_t* Wt_in_a = (bf16_t*)(ws + WS_WIN_A); bf16_t* Wt_out_a = (bf16_t*)(ws + WS_WOUT_A); bf16_t* Wt_cat = (bf16_t*)(ws + WS_WCAT); bf16_t* Wt_out_b = (bf16_t*)(ws + WS_WOUT_B);
    float* cs = (float*)(ws + WS_CS);
    bf16_t* XN = (bf16_t*)(ws + WS_XN); bf16_t* S0 = (bf16_t*)(ws + WS_S0); bf16_t* S2 = (bf16_t*)(ws + WS_S2);
    float* Y = (float*)(ws + WS_Y);
    bf16_t* S1 = (bf16_t*)(ws + WS_S1); bf16_t* S3 = (bf16_t*)(ws + WS_S3);

    for (int u = F.tid; u < (LDS_BYTES - LDSCTL_OFF) / 4; u += NWAVES * 64) ((LAS unsigned*)(F.lds + LDSCTL_OFF))[u] = 0u;
    __syncthreads();
    XcdBarrier bar = xcd_barrier_post((unsigned*)(F.ctl + CW_BAR) + args.li * XCD_BAR_WORDS, F.MISC + 8);
    const int lo = args.ph_lo, hi = args.ph_hi;
#define IN(k) (lo <= (k) && (k) < hi)
#define BOTH(k) (IN(k) && IN((k) + 1))
    const int gw = F.vcu * NWAVES + F.wave, NGW = F.G * NWAVES;

    if (IN(0)) {
        LAS float* scr = (LAS float*)(F.lds + RING_OFF + F.wave * 16384);
        constexpr int I_IN = 16 * 128, I_OUT = 16 * 32, I_KV = 16 * 64;
        constexpr int NITEMS = I_IN + I_OUT + 2 * I_KV + I_OUT;
        for (int it = gw; it < NITEMS; it += NGW) {
            int r = it;
            if (r < I_IN) { p0_transpose_item(a_w_in, a_norm_pre, 1024, 4096, Wt_in_a, 0, scr, r, F.lane); continue; } r -= I_IN;
            if (r < I_OUT) { p0_transpose_item(a_w_out, nullptr, 1024, 1024, Wt_out_a, 0, scr, r, F.lane); continue; } r -= I_OUT;
            if (r < I_KV) { p0_transpose_item(kv_w, kv_norm, 1024, 2048, Wt_cat, 0, scr, r, F.lane); continue; } r -= I_KV;
            if (r < I_KV) { p0_transpose_item(b_w_in, b_norm_pre, 1024, 2048, Wt_cat, 2048, scr, r, F.lane); continue; } r -= I_KV;
            p0_transpose_item(b_w_out, nullptr, 1024, 1024, Wt_out_b, 0, scr, r, F.lane);
        }
        for (int m = gw; m < T; m += NGW) rms_row_to_bf16(F.lane, x + (size_t)m * DM, XN + (size_t)m * DM);
        for (int idx = blockIdx.x * 512 + F.tid; idx < T * 8; idx += F.G * 512) {
            const int t = idx >> 3, i = idx & 7;
            const float inv = powf(500000.0f, -(float)i * 0.125f);
            const float ang = (float)pos[t] * inv;
            cs[t * 16 + i] = cosf(ang); cs[t * 16 + 8 + i] = sinf(ang);
        }
        if (BOTH(0)) xcd_barrier(bar);
    }
    if (IN(1)) {
        pg8::Gemm g{XN, Wt_in_a, T, 4096, 1024}; pg8::StaticOrder S; S.init(T, 4096, F.G, (int)blockIdx.x);
        pg8::EpiSplit E{S0, SPL, 0, C2, 0u, cs};
        pg8::gemm_phase<pg8::EpiSplit, pg8::StaticOrder, true, true>(F.lds + RING_OFF, g, S, E);
        if (BOTH(1)) xcd_barrier(bar);
    }
    if (IN(2)) {
        for (int bh = F.vcu; bh < BATCH * 16; bh += F.G)
            for (int u = 0; u < 8; ++u) att::attn_a_unit(bh >> 4, bh & 15, u, S0, S1, S2, S3, S0, pos, a_rel_bias, (att::lds_u8*)(F.lds + RING_OFF));
        if (BOTH(2)) xcd_barrier(bar);
    }
    if (IN(3)) {
        pg8::Gemm g{S0, Wt_out_a, T, 1024, 1024}; pg8::StaticOrder S; S.init(T, 1024, F.G, (int)blockIdx.x);
        pg8::EpiF32 E{Y, 1024};
        pg8::gemm_phase<pg8::EpiF32, pg8::StaticOrder, true, true>(F.lds + RING_OFF, g, S, E);
        if (BOTH(3)) xcd_barrier(bar);
    }
    if (IN(4)) {
        for (int m = gw; m < T; m += NGW) resnorm_row(F.lane, x + (size_t)m * DM, Y + (size_t)m * DM, a_norm_post, out + (size_t)m * DM, XN + (size_t)m * DM);
        if (BOTH(4)) xcd_barrier(bar);
    }
    if (IN(5)) {
        pg8::Gemm g{XN, Wt_cat, T, 4096, 1024}; pg8::StaticOrder S; S.init(T, 4096, F.G, (int)blockIdx.x);
        pg8::EpiSplit E{S0, SPL, 2, C2, 0x5u, cs};
        pg8::gemm_phase<pg8::EpiSplit, pg8::StaticOrder, true, true>(F.lds + RING_OFF, g, S, E);
        if (BOTH(5)) xcd_barrier(bar);
    }
    if (IN(6)) {
        float lam; { float a = lq1[F.lane] * lk1[F.lane], c = lq2[F.lane] * lk2[F.lane]; a = wave_sum(a); c = wave_sum(c); lam = __expf(a) - __expf(c) + LAM_INIT; }
        for (int v = F.vcu; v < BATCH * 8 * 2; v += F.G) { const int bh = v >> 1, s = v & 1;
            for (int j = 0; j < 8; ++j) { const int base = 2 * (j >> 1) + s, qb = (j & 1) ? 15 - base : base;
                att::attn_b_unit(bh >> 3, bh & 7, qb, S2, S0, S1, S3, S2, b_subln, lam, (att::lds_u8*)(F.lds + RING_OFF)); } }
        if (BOTH(6)) xcd_barrier(bar);
    }
    if (IN(7)) {
        pg8::Gemm g{S2, Wt_out_b, T, 1024, 1024}; pg8::StaticOrder S; S.init(T, 1024, F.G, (int)blockIdx.x);
        pg8::EpiF32 E{Y, 1024};
        pg8::gemm_phase<pg8::EpiF32, pg8::StaticOrder, true, true>(F.lds + RING_OFF, g, S, E);
        if (BOTH(7)) xcd_barrier(bar);
    }
    if (IN(8)) {
        for (int m = gw; m < T; m += NGW) resnorm_row(F.lane, out + (size_t)m * DM, Y + (size_t)m * DM, b_norm_post, out + (size_t)m * DM, nullptr);
    }
#undef IN
#undef BOTH
}

extern "C" void kernel_launch(void* const* d_in, const int* in_sizes, int n_in, void* d_out, int out_size, void* d_ws, size_t ws_size, hipStream_t stream) {
    static int grid = 0;
    if (grid == 0) {
        if (n_in != 18 || out_size != T * DM || ws_size < WS_END) { fprintf(stderr, "kernel_launch: unexpected shapes (n_in %d out %d ws %zu)\n", n_in, out_size, ws_size); grid = -1; return; }
        int dev = 0, cus = 0;
        if (hipGetDevice(&dev) != hipSuccess || hipDeviceGetAttribute(&cus, hipDeviceAttributeMultiprocessorCount, dev) != hipSuccess) { grid = -1; return; }
        if (hipFuncSetAttribute((const void*)mega_fwd, hipFuncAttributeMaxDynamicSharedMemorySize, LDS_BYTES) != hipSuccess) { fprintf(stderr, "kernel_launch: hipFuncSetAttribute failed\n"); grid = -1; return; }
        grid = cus;
    }
    if (grid < 0) return;
    (void)hipMemsetAsync((char*)d_ws + WS_CTL, 0, CTL_ZERO_BYTES, stream);
    Args a{};
    for (int i = 0; i < 18; ++i) a.in[i] = (const float*)d_in[i];
    a.out = (float*)d_out; a.ws = (unsigned char*)d_ws;
    unsigned char* ws = (unsigned char*)d_ws; (void)ws;
    int lo = 0, li = 0;
#define MEGA(l_, h_) do { a.ph_lo = (l_); a.ph_hi = (h_); a.li = li++; hipLaunchKernelGGL(mega_fwd, dim3(grid), dim3(NWAVES * 64), LDS_BYTES, stream, a); } while (0)
#if HYBRID & 1
    { bf16_t* S0 = (bf16_t*)(ws + WS_S0); bf16_t* S1 = (bf16_t*)(ws + WS_S1); bf16_t* S2 = (bf16_t*)(ws + WS_S2); bf16_t* S3 = (bf16_t*)(ws + WS_S3);
      MEGA(lo, 2); attn_a_naive<<<T * 16 / 64, 64, 0, stream>>>(S0, S1, S2, S3, (const int*)d_in[1], (const float*)d_in[4], S0); lo = 3; }
#endif
#if HYBRID & 2
    { bf16_t* S0 = (bf16_t*)(ws + WS_S0); bf16_t* S1 = (bf16_t*)(ws + WS_S1); bf16_t* S2 = (bf16_t*)(ws + WS_S2); bf16_t* S3 = (bf16_t*)(ws + WS_S3);
      MEGA(lo, 6); attn_b_naive<<<T * 8 * 2 / 64, 64, 0, stream>>>(S2, S0, S1, S3, (const float*)d_in[11], (const float*)d_in[12], (const float*)d_in[13], (const float*)d_in[14], (const float*)d_in[15], S2); lo = 7; }
#endif
    MEGA(lo, 9);
#undef MEGA
}
```

```cpp
#include <hip/hip_runtime.h>
#include <cstdint>
#include <cstdio>

#ifndef HYBRID
#define HYBRID 0
#endif

#ifndef DUP
#define DUP (-1)
#endif

typedef unsigned short bf16_t;
constexpr int BATCH = 16, SEQ = 2048, DM = 1024, T = BATCH * SEQ;
constexpr int CHUNK = 64, PAST = 8, MAXREL = 128, NREL = 257;
constexpr float EPS = 1e-6f;
constexpr float LAM_INIT = 0.35550906759096924f;
constexpr float LOG2E = 1.4426950408889634f;
constexpr float C2 = 0.125f * LOG2E;

__device__ __forceinline__ float bf2f(bf16_t v) { return __uint_as_float((unsigned)v << 16); }
__device__ __forceinline__ bf16_t f2bf(float f) { unsigned u = __float_as_uint(f); return (bf16_t)((u + 0x7fffu + ((u >> 16) & 1u)) >> 16); }

#if HYBRID
__global__ void __launch_bounds__(64) attn_a_naive(const bf16_t* Q, const bf16_t* Kb, const bf16_t* Vb, const bf16_t* G, const int* pos, const float* relb, bf16_t* OG) {
    int gid = blockIdx.x * 64 + threadIdx.x;
    int q = gid & (SEQ - 1), h = (gid >> 11) & 15, b = gid >> 15;
    int c = q >> 6;
    size_t trow = (size_t)b * SEQ + q;
    float qv[64];
#pragma unroll
    for (int d = 0; d < 64; ++d) qv[d] = bf2f(Q[trow * DM + h * 64 + d]);
    int qpos = pos[trow];
    const float* rb = relb + h * NREL;
    int kstart = (c - PAST) * CHUNK; if (kstart < 0) kstart = 0;
    int kend = (c + 1) * CHUNK;
    float m = -1e30f, l = 0.f;
    for (int k = kstart; k < kend; ++k) {
        size_t krow = (size_t)b * SEQ + k;
        const uint4* kp = (const uint4*)(Kb + krow * DM + h * 64);
        float s = 0.f;
#pragma unroll
        for (int j = 0; j < 8; ++j) { uint4 w = kp[j]; unsigned ww[4] = {w.x, w.y, w.z, w.w};
#pragma unroll
            for (int e = 0; e < 4; ++e) { s += qv[j * 8 + 2 * e] * __uint_as_float(ww[e] << 16) + qv[j * 8 + 2 * e + 1] * __uint_as_float(ww[e] & 0xffff0000u); } }
        int rel = qpos - pos[krow]; rel = rel < -MAXREL ? -MAXREL : (rel > MAXREL ? MAXREL : rel);
        s = s + rb[rel + MAXREL] * LOG2E;
        float mn = fmaxf(m, s);
        l = l * exp2f(m - mn) + exp2f(s - mn); m = mn;
    }
    float o[64];
#pragma unroll
    for (int d = 0; d < 64; ++d) o[d] = 0.f;
    float il = 1.f / l;
    for (int k = kstart; k < kend; ++k) {
        size_t krow = (size_t)b * SEQ + k;
        const uint4* kp = (const uint4*)(Kb + krow * DM + h * 64);
        float s = 0.f;
#pragma unroll
        for (int j = 0; j < 8; ++j) { uint4 w = kp[j]; unsigned ww[4] = {w.x, w.y, w.z, w.w};
#pragma unroll
            for (int e = 0; e < 4; ++e) { s += qv[j * 8 + 2 * e] * __uint_as_float(ww[e] << 16) + qv[j * 8 + 2 * e + 1] * __uint_as_float(ww[e] & 0xffff0000u); } }
        int rel = qpos - pos[krow]; rel = rel < -MAXREL ? -MAXREL : (rel > MAXREL ? MAXREL : rel);
        s = s + rb[rel + MAXREL] * LOG2E;
        float p = exp2f(s - m) * il;
        const uint4* vp = (const uint4*)(Vb + krow * DM + h * 64);
#pragma unroll
        for (int j = 0; j < 8; ++j) { uint4 w = vp[j]; unsigned ww[4] = {w.x, w.y, w.z, w.w};
#pragma unroll
            for (int e = 0; e < 4; ++e) { o[j * 8 + 2 * e] += p * __uint_as_float(ww[e] << 16); o[j * 8 + 2 * e + 1] += p * __uint_as_float(ww[e] & 0xffff0000u); } }
    }
#pragma unroll
    for (int d = 0; d < 64; ++d) {
        float g = bf2f(G[trow * DM + h * 64 + d]);
        float sg = g / (1.f + __expf(-g));
        OG[trow * DM + h * 64 + d] = f2bf(o[d] * sg);
    }
}

__global__ void __launch_bounds__(64) attn_b_naive(const bf16_t* Q, const bf16_t* Kb, const bf16_t* Vb, const bf16_t* G,
                                                   const float* lq1, const float* lk1, const float* lq2, const float* lk2, const float* subln, bf16_t* OG) {
    int gid = blockIdx.x * 64 + threadIdx.x;
    int m = gid & 1, rowid = gid >> 1;
    int q = rowid & (SEQ - 1), h = (rowid >> 11) & 7, b = rowid >> 14;
    float d1 = 0.f, d2 = 0.f;
    for (int i = 0; i < 64; ++i) { d1 += lq1[i] * lk1[i]; d2 += lq2[i] * lk2[i]; }
    float lam = __expf(d1) - __expf(d2) + LAM_INIT;
    size_t trow = (size_t)b * SEQ + q;
    float qv[64];
#pragma unroll
    for (int d = 0; d < 64; ++d) qv[d] = bf2f(Q[trow * DM + h * 128 + m * 64 + d]);
    int kend = ((q >> 6) + 1) * CHUNK;
    float mx = -1e30f, l = 0.f;
    for (int k = 0; k < kend; ++k) {
        size_t krow = (size_t)b * SEQ + k;
        const uint4* kp = (const uint4*)(Kb + krow * DM + h * 128 + m * 64);
        float s = 0.f;
#pragma unroll
        for (int j = 0; j < 8; ++j) { uint4 w = kp[j]; unsigned ww[4] = {w.x, w.y, w.z, w.w};
#pragma unroll
            for (int e = 0; e < 4; ++e) { s += qv[j * 8 + 2 * e] * __uint_as_float(ww[e] << 16) + qv[j * 8 + 2 * e + 1] * __uint_as_float(ww[e] & 0xffff0000u); } }
        float mn = fmaxf(mx, s);
        l = l * exp2f(mx - mn) + exp2f(s - mn); mx = mn;
    }
    float o[64];
#pragma unroll
    for (int d = 0; d < 64; ++d) o[d] = 0.f;
    float il = 1.f / l;
    for (int k = 0; k < kend; ++k) {
        size_t krow = (size_t)b * SEQ + k;
        const uint4* kp = (const uint4*)(Kb + krow * DM + h * 128 + m * 64);
        float s = 0.f;
#pragma unroll
        for (int j = 0; j < 8; ++j) { uint4 w = kp[j]; unsigned ww[4] = {w.x, w.y, w.z, w.w};
#pragma unroll
            for (int e = 0; e < 4; ++e) { s += qv[j * 8 + 2 * e] * __uint_as_float(ww[e] << 16) + qv[j * 8 + 2 * e + 1] * __uint_as_float(ww[e] & 0xffff0000u); } }
        float p = exp2f(s - mx) * il;
        float po = __shfl_xor(p, 1);
        float p0 = m ? po : p, p1 = m ? p : po;
        float a = p0 - lam * p1;
        const uint4* vp = (const uint4*)(Vb + krow * DM + h * 128 + m * 64);
#pragma unroll
        for (int j = 0; j < 8; ++j) { uint4 w = vp[j]; unsigned ww[4] = {w.x, w.y, w.z, w.w};
#pragma unroll
            for (int e = 0; e < 4; ++e) { o[j * 8 + 2 * e] += a * __uint_as_float(ww[e] << 16); o[j * 8 + 2 * e + 1] += a * __uint_as_float(ww[e] & 0xffff0000u); } }
    }
    float ss = 0.f;
#pragma unroll
    for (int d = 0; d < 64; ++d) ss += o[d] * o[d];
    ss += __shfl_xor(ss, 1);
    float r = rsqrtf(ss * (1.f / 128.f) + EPS) * (1.f - LAM_INIT);
#pragma unroll
    for (int d = 0; d < 64; ++d) {
        int c = h * 128 + m * 64 + d;
        float g = bf2f(G[trow * DM + c]);
        float sg = g / (1.f + __expf(-g));
        OG[trow * DM + c] = f2bf(o[d] * r * subln[m * 64 + d] * sg);
    }
}
#endif
namespace pg8 {
#define PG8_LAS __attribute__((address_space(3)))
typedef unsigned short bf16_t;
typedef short bf16x8 __attribute__((ext_vector_type(8)));
typedef float f32x4 __attribute__((ext_vector_type(4)));
typedef unsigned u32x4 __attribute__((ext_vector_type(4)));
constexpr int BM = 256, BK = 64, HALF = 128, HTB = HALF * BK * 2  , STAGE_BYTES = 8 * HTB, NXCD = 8, WGM = 8;

__host__ __device__ __forceinline__ int lds_byte(int r, int c) { const int st = (r >> 4) * 2 + (c >> 5), rr = r & 15, cc = c & 31, ob = rr * 64 + cc * 2; return st * 1024 + (ob ^ (((ob >> 9) & 1) << 5)); }
__host__ __device__ __forceinline__ void stage_rc(int b, int& R, int& C) { const int st = b / 1024, sb = b % 1024, swz = sb ^ (((sb >> 9) & 1) << 5); R = (st >> 1) * 16 + swz / 64; C = (st & 1) * 32 + (swz % 64) / 2; }
__host__ __device__ __forceinline__ int perm32(int rho) { const int n = rho >> 4, i = rho & 15; return 8 * (i >> 2) + 4 * n + (i & 3); }

struct Unit { int pm, pn; };
struct Gemm { const bf16_t* A; const bf16_t* Bt; int M, N, K; };

struct StaticOrder {
    int nM, nN, nwg, G, c;
    __host__ __device__ void init(int M, int N, int G_, int c_) { nM = M / BM; nN = N / BM; nwg = nM * nN; G = G_; c = c_; }
    __host__ __device__ bool next(int i, Unit& u) const {
        const long L = (long)i * G + c; if (L >= nwg) return false;
        int wgid = (int)L; { const int q = nwg / NXCD, r = nwg % NXCD, xcd = wgid % NXCD, off = wgid / NXCD; wgid = (xcd < r ? xcd * (q + 1) : r * (q + 1) + (xcd - r) * q) + off; }
        const int nig = WGM * nN, gid = wgid / nig, fm = gid * WGM, gsz = (nM - fm) < WGM ? (nM - fm) : WGM;
        u.pm = fm + ((wgid % nig) % gsz); u.pn = (wgid % nig) / gsz; return true;
    }
    __device__ __forceinline__ void a_ready(const Unit&) const {}
    __device__ __forceinline__ void done(const Unit&) const {}
};

__device__ __forceinline__ unsigned cvt_pk_bf16(float lo, float hi) { unsigned r; asm volatile("v_cvt_pk_bf16_f32 %0, %1, %2" : "=v"(r) : "v"(lo), "v"(hi)); return r; }
struct EpiSplit {
    static constexpr bool PERM = true, AFTER_DRAIN = false;
    bf16_t* O; size_t split_stride; int scale_split; float scale; unsigned rope_mask; const float* cs;
    __device__ __forceinline__ void operator()(const f32x4 (&acc)[2][2][4][2], const Unit& u, int wr, int wc, int fr, int fq) const {
        const int row0 = u.pm * BM + wr * 64 + fr; int colt = u.pn * BM;
        const int t = colt >> 10; bf16_t* base = O + (size_t)t * split_stride; colt &= 1023;
        const float sc = (t == scale_split) ? scale : 1.f;
        const int col0 = colt + wc * 32 + 8 * fq;
        const bool rope = ((rope_mask >> t) & 1u) && !(wc & 1);
#pragma unroll
        for (int ai = 0; ai < 2; ++ai)
#pragma unroll
            for (int m = 0; m < 4; ++m) {
                const int row = row0 + ai * HALF + m * 16;
                bf16_t* rowp = base + (size_t)row * 1024 + col0;
                f32x4 c0 = {1.f, 1.f, 1.f, 1.f}, c1 = c0, s0 = {0.f, 0.f, 0.f, 0.f}, s1 = s0;
                if (rope) { const f32x4* cp = (const f32x4*)(cs + (size_t)row * 16); c0 = cp[0]; c1 = cp[1]; s0 = cp[2]; s1 = cp[3];
                    if (fq == 0) { s0 = -s0; s1 = -s1; } else if (fq >= 2) { c0 = (f32x4){1.f, 1.f, 1.f, 1.f}; c1 = c0; s0 = (f32x4){0.f, 0.f, 0.f, 0.f}; s1 = s0; } }
#pragma unroll
                for (int bj = 0; bj < 2; ++bj) { f32x4 v0 = acc[ai][bj][m][0], v1 = acc[ai][bj][m][1];
                    if (rope) { f32x4 p0, p1;
#pragma unroll
                        for (int e = 0; e < 4; ++e) { p0[e] = __shfl_xor(v0[e], 16); p1[e] = __shfl_xor(v1[e], 16); }
                        v0 = v0 * c0 + p0 * s0; v1 = v1 * c1 + p1 * s1; }
                    v0 = v0 * sc; v1 = v1 * sc; u32x4 w; w.x = cvt_pk_bf16(v0[0], v0[1]); w.y = cvt_pk_bf16(v0[2], v0[3]); w.z = cvt_pk_bf16(v1[0], v1[1]); w.w = cvt_pk_bf16(v1[2], v1[3]);
                    *(u32x4*)(rowp + bj * HALF) = w; } }
    }
};
struct EpiF32 {
    static constexpr bool PERM = false, AFTER_DRAIN = false;
    float* C; int ldc;
    __device__ __forceinline__ void operator()(const f32x4 (&acc)[2][2][4][2], const Unit& u, int wr, int wc, int fr, int fq) const {
        const int row0 = u.pm * BM + wr * 64 + fr, col0 = u.pn * BM + wc * 32 + 4 * fq;
#pragma unroll
        for (int ai = 0; ai < 2; ++ai)
#pragma unroll
            for (int m = 0; m < 4; ++m) { float* rowp = C + (size_t)(row0 + ai * HALF + m * 16) * ldc + col0;
#pragma unroll
                for (int bj = 0; bj < 2; ++bj)
#pragma unroll
                    for (int n = 0; n < 2; ++n) *(f32x4*)(rowp + bj * HALF + n * 16) = acc[ai][bj][m][n]; }
    }
};
template <class Epi, class Sched, bool ALIGN_EPI = false, bool SP2 = false>
__device__ __forceinline__ void gemm_phase(PG8_LAS unsigned char* lds, const Gemm g, const Sched& S, const Epi& E) {
    const int tid = threadIdx.x, wid = __builtin_amdgcn_readfirstlane(tid >> 6), lane = tid & 63, wr = wid >> 2, wc = wid & 3, fr = lane & 15, fq = lane >> 4;
    const int K = g.K, nt = K / BK;
    unsigned voffA[2], voffB[2];
#pragma unroll
    for (int i = 0; i < 2; ++i) { int R, C; stage_rc(tid * 16 + i * 8192, R, C); const int Rb = Epi::PERM ? ((R & ~31) + perm32(R & 31)) : R;
        voffA[i] = (unsigned)(R * K + C) * 2u; voffB[i] = (unsigned)(Rb * K + C) * 2u; }
    const size_t kstep = (size_t)(BK * 2);
    const size_t hstep = (size_t)HALF * K * 2;
    const size_t tstep = 2 * hstep;
    const unsigned ldsw = (unsigned)wid * 1024u;
    const int aoff = lds_byte(wr * 64 + fr, fq * 8), boff = lds_byte(wc * 32 + fr, fq * 8);
#define PG8_SA(b, h) (((b) * 2 + (h)) * HTB)
#define PG8_SB(b, h) ((4 + (b) * 2 + (h)) * HTB)
#define PG8_STAGE(bufoff, gbase, voff) do { _Pragma("unroll") for (int _i = 0; _i < 2; ++_i) \
        __builtin_amdgcn_global_load_lds((const unsigned*)((const char*)(gbase) + (voff)[_i]), (PG8_LAS unsigned*)(lds + (bufoff) + ldsw + _i * 8192), 16, 0, 0); } while (0)
#define PG8_LDA(dst, b, h) do { _Pragma("unroll") for (int m = 0; m < 4; ++m) _Pragma("unroll") for (int k = 0; k < 2; ++k) dst[m][k] = *(const PG8_LAS bf16x8*)(lds + PG8_SA(b, h) + aoff + m * 2048 + k * 1024); } while (0)
#define PG8_LDB(dst, b, h) do { _Pragma("unroll") for (int n = 0; n < 2; ++n) _Pragma("unroll") for (int k = 0; k < 2; ++k) dst[n][k] = *(const PG8_LAS bf16x8*)(lds + PG8_SB(b, h) + boff + n * 2048 + k * 1024); } while (0)
#define PG8_MMA(ai, bj, At, Bt) do { __builtin_amdgcn_s_setprio(1); _Pragma("unroll") for (int m = 0; m < 4; ++m) _Pragma("unroll") for (int n = 0; n < 2; ++n) _Pragma("unroll") for (int k = 0; k < 2; ++k) \
        acc[ai][bj][m][n] = __builtin_amdgcn_mfma_f32_16x16x32_bf16(Bt[n][k], At[m][k], acc[ai][bj][m][n], 0, 0, 0); __builtin_amdgcn_s_setprio(0); } while (0)
#define PG8_WAIT_V(n) asm volatile("s_waitcnt vmcnt(" #n ")" ::: "memory")
#define PG8_WAIT_L(n) asm volatile("s_waitcnt lgkmcnt(" #n ")" ::: "memory")
#define PG8_BAR __builtin_amdgcn_s_barrier()
#define PG8_SCHED __builtin_amdgcn_sched_barrier(0)
    Unit cur, nxt; int ui = 0;
    if (!S.next(0, cur)) return;
    f32x4 acc[2][2][4][2];
#pragma unroll
    for (int a = 0; a < 2; ++a)
#pragma unroll
        for (int b = 0; b < 2; ++b)
#pragma unroll
            for (int m = 0; m < 4; ++m)
#pragma unroll
                for (int n = 0; n < 2; ++n) acc[a][b][m][n] = (f32x4){0.f, 0.f, 0.f, 0.f};
    bf16x8 At[4][2], B0[2][2], B1[2][2];
    const char* cA = (const char*)g.A + (size_t)cur.pm * tstep; const char* cB = (const char*)g.Bt + (size_t)cur.pn * tstep;
    S.a_ready(cur);
    if constexpr (SP2) {
        PG8_STAGE(PG8_SB(0, 0), cB, voffB); PG8_STAGE(PG8_SB(0, 1), cB + hstep, voffB); PG8_STAGE(PG8_SA(0, 0), cA, voffA); PG8_STAGE(PG8_SA(0, 1), cA + hstep, voffA);
        if (wr == 1) PG8_BAR;
        PG8_WAIT_V(2); PG8_BAR;
        PG8_STAGE(PG8_SB(1, 0), cB + kstep, voffB); PG8_STAGE(PG8_SA(1, 0), cA + kstep, voffA); PG8_STAGE(PG8_SB(1, 1), cB + hstep + kstep, voffB);
        PG8_WAIT_V(6); PG8_BAR;
    } else {
        PG8_STAGE(PG8_SB(0, 0), cB, voffB); PG8_STAGE(PG8_SA(0, 0), cA, voffA); PG8_STAGE(PG8_SB(0, 1), cB + hstep, voffB); PG8_STAGE(PG8_SA(0, 1), cA + hstep, voffA);
        if (wr == 1) PG8_BAR;
        PG8_WAIT_V(4); PG8_BAR;
        PG8_STAGE(PG8_SB(1, 0), cB + kstep, voffB); PG8_STAGE(PG8_SA(1, 0), cA + kstep, voffA); PG8_STAGE(PG8_SB(1, 1), cB + hstep + kstep, voffB);
        PG8_WAIT_V(6); PG8_BAR;
    }
    for (;;) {
        const bool has_next = S.next(ui + 1, nxt);
        const char* nA = has_next ? (const char*)g.A + (size_t)nxt.pm * tstep : cA; const char* nB = has_next ? (const char*)g.Bt + (size_t)nxt.pn * tstep : cB;
        for (int t = 0; t < nt; t += 2) {
            const bool last = (t == nt - 2);
            const char* a1 = cA + (size_t)(t + 1) * kstep;
            const char* a2 = last ? nA : cA + (size_t)(t + 2) * kstep; const char* b2 = last ? nB : cB + (size_t)(t + 2) * kstep;
            const char* a3 = a2 + kstep; const char* b3 = b2 + kstep;
            if (last && has_next) S.a_ready(nxt);
            if constexpr (SP2) {
            PG8_LDB(B0, 0, 0); PG8_LDB(B1, 0, 1); PG8_SCHED; PG8_LDA(At, 0, 0); PG8_STAGE(PG8_SA(1, 1), a1 + hstep, voffA);
            PG8_WAIT_V(8); PG8_WAIT_L(0); PG8_BAR; PG8_MMA(0, 0, At, B0); PG8_MMA(0, 1, At, B1); PG8_BAR; PG8_SCHED;
            PG8_LDA(At, 0, 1); PG8_STAGE(PG8_SB(0, 0), b2, voffB); PG8_STAGE(PG8_SB(0, 1), b2 + hstep, voffB); PG8_STAGE(PG8_SA(0, 0), a2, voffA);
            PG8_WAIT_V(8); PG8_WAIT_L(0); PG8_BAR; PG8_MMA(1, 0, At, B0); PG8_MMA(1, 1, At, B1); PG8_BAR; PG8_SCHED;
            PG8_LDB(B0, 1, 0); PG8_LDB(B1, 1, 1); PG8_SCHED; PG8_LDA(At, 1, 0); PG8_STAGE(PG8_SA(0, 1), a2 + hstep, voffA);
            PG8_WAIT_V(8); PG8_WAIT_L(0); PG8_BAR; PG8_MMA(0, 0, At, B0); PG8_MMA(0, 1, At, B1); PG8_BAR; PG8_SCHED;
            PG8_LDA(At, 1, 1); PG8_STAGE(PG8_SB(1, 0), b3, voffB); PG8_STAGE(PG8_SB(1, 1), b3 + hstep, voffB); PG8_STAGE(PG8_SA(1, 0), a3, voffA);
            PG8_WAIT_V(8); PG8_WAIT_L(0); PG8_BAR; PG8_MMA(1, 0, At, B0); PG8_MMA(1, 1, At, B1); PG8_BAR; PG8_SCHED;
            } else {
            PG8_LDB(B0, 0, 0); PG8_SCHED; PG8_LDA(At, 0, 0); PG8_STAGE(PG8_SA(1, 1), a1 + hstep, voffA);
            PG8_WAIT_L(8); PG8_BAR; PG8_WAIT_L(0); PG8_MMA(0, 0, At, B0); PG8_BAR; PG8_SCHED;
            PG8_LDB(B1, 0, 1); PG8_STAGE(PG8_SB(0, 0), b2, voffB);
            PG8_BAR; PG8_WAIT_L(0); PG8_MMA(0, 1, At, B1); PG8_BAR;
            PG8_LDA(At, 0, 1); PG8_STAGE(PG8_SA(0, 0), a2, voffA);
            PG8_BAR; PG8_WAIT_L(0); PG8_MMA(1, 0, At, B0); PG8_BAR; PG8_SCHED;
            PG8_STAGE(PG8_SB(0, 1), b2 + hstep, voffB);
            PG8_WAIT_V(6); PG8_BAR; PG8_MMA(1, 1, At, B1); PG8_BAR;
            PG8_LDB(B0, 1, 0); PG8_SCHED; PG8_LDA(At, 1, 0); PG8_STAGE(PG8_SA(0, 1), a2 + hstep, voffA);
            PG8_WAIT_L(8); PG8_BAR; PG8_WAIT_L(0); PG8_MMA(0, 0, At, B0); PG8_BAR; PG8_SCHED;
            PG8_LDB(B1, 1, 1); PG8_STAGE(PG8_SB(1, 0), b3, voffB);
            PG8_BAR; PG8_WAIT_L(0); PG8_MMA(0, 1, At, B1); PG8_BAR;
            PG8_LDA(At, 1, 1); PG8_STAGE(PG8_SA(1, 0), a3, voffA);
            PG8_BAR; PG8_WAIT_L(0); PG8_MMA(1, 0, At, B0); PG8_BAR; PG8_SCHED;
            PG8_STAGE(PG8_SB(1, 1), b3 + hstep, voffB);
            PG8_WAIT_V(6); PG8_BAR; PG8_MMA(1, 1, At, B1); PG8_BAR;
            }
        }
        if constexpr (ALIGN_EPI) { if (wr == 0) PG8_BAR; }
        if constexpr (!Epi::AFTER_DRAIN) { E(acc, cur, wr, wc, fr, fq); S.done(cur); }
        if (!has_next) break;
#pragma unroll
        for (int a = 0; a < 2; ++a)
#pragma unroll
            for (int b = 0; b < 2; ++b)
#pragma unroll
                for (int m = 0; m < 4; ++m)
#pragma unroll
                    for (int n = 0; n < 2; ++n) acc[a][b][m][n] = (f32x4){0.f, 0.f, 0.f, 0.f};
        cur = nxt; cA = nA; cB = nB; ++ui;
        if constexpr (ALIGN_EPI) { if (wr == 1) PG8_BAR; }
    }
    PG8_WAIT_V(0);
    if constexpr (!ALIGN_EPI) { if (wr == 0) PG8_BAR; }
    PG8_BAR;
    if constexpr (Epi::AFTER_DRAIN) { E.fused(acc, cur, wr, wc, fr, fq, lds, wid, lane); S.done(cur); }
#undef PG8_SA
#undef PG8_SB
#undef PG8_STAGE
#undef PG8_LDA
#undef PG8_LDB
#undef PG8_MMA
#undef PG8_WAIT_V
#undef PG8_WAIT_L
#undef PG8_BAR
#undef PG8_SCHED
}
}
namespace att {
#define ATT_LAS __attribute__((address_space(3)))
typedef ATT_LAS unsigned char lds_u8;
typedef const ATT_LAS unsigned char* lds_cptr;
using bf16x8 = __attribute__((ext_vector_type(8))) short;
using s16x4 = __attribute__((ext_vector_type(4))) short;
using f32x16 = __attribute__((ext_vector_type(16))) float;
using u32x4 = __attribute__((ext_vector_type(4))) unsigned;
using f32x4 = __attribute__((ext_vector_type(4))) float;
typedef float f32x2_t __attribute__((ext_vector_type(2))); typedef __bf16 bf16x2_t __attribute__((ext_vector_type(2)));
__device__ __forceinline__ int crow(int r, int hi) { return (r & 3) + 8 * (r >> 2) + 4 * hi; }
#define ATT_SBAR() __builtin_amdgcn_sched_barrier(0)
#define ATT_WAIT_BAR(N) asm volatile("s_waitcnt vmcnt(" #N ") lgkmcnt(0)\n\ts_barrier" ::: "memory")
__device__ __forceinline__ void glds16(const void* gsrc, unsigned lds_dst) { unsigned keep;
    asm volatile("s_mov_b32 %0, m0\n\ts_mov_b32 m0, %2\n\ts_nop 0\n\tglobal_load_lds_dwordx4 %1, off\n\ts_mov_b32 m0, %0" : "=&s"(keep) : "v"(gsrc), "s"(lds_dst) : "memory"); }
__device__ __forceinline__ unsigned cvtpk(float lo, float hi) { f32x2_t v = {lo, hi}; bf16x2_t b = __builtin_convertvector(v, bf16x2_t); return __builtin_bit_cast(unsigned, b); }
__device__ __forceinline__ float silu(float g) { return g * __builtin_amdgcn_rcpf(1.f + __builtin_amdgcn_exp2f(-g * LOG2E)); }

__device__ __forceinline__ void qkt(f32x16& p0, f32x16& p1, lds_cptr kslot, const bf16x8* qr, const int* koff) {
    const f32x16 z = {};
#pragma unroll
    for (int d0 = 0; d0 < 4; ++d0) {
        const bf16x8 b0 = *(const ATT_LAS bf16x8*)(kslot + koff[d0]);
        const bf16x8 b1 = *(const ATT_LAS bf16x8*)(kslot + koff[d0] + 4096);
        if (d0 == 0) { p0 = __builtin_amdgcn_mfma_f32_32x32x16_bf16(b0, qr[0], z, 0, 0, 0); p1 = __builtin_amdgcn_mfma_f32_32x32x16_bf16(b1, qr[0], z, 0, 0, 0); }
        else { p0 = __builtin_amdgcn_mfma_f32_32x32x16_bf16(b0, qr[d0], p0, 0, 0, 0); p1 = __builtin_amdgcn_mfma_f32_32x32x16_bf16(b1, qr[d0], p1, 0, 0, 0); }
    }
}
__device__ __forceinline__ float rowmax(const f32x16& p0, const f32x16& p1) {
    float a = fmaxf(p0[0], p1[0]);
#pragma unroll
    for (int r = 1; r < 16; ++r) a = fmaxf(a, fmaxf(p0[r], p1[r]));
    auto rr = __builtin_amdgcn_permlane32_swap(__float_as_uint(a), __float_as_uint(a), false, false);
    return fmaxf(__uint_as_float(rr[0]), __uint_as_float(rr[1]));
}
template <int NDV> __device__ __forceinline__ void pv(f32x16* o, const int* vb, bf16x8 pa0, bf16x8 pa1, bf16x8 pa2, bf16x8 pa3) {
    constexpr int RS = NDV * 64;
#pragma unroll
    for (int d0 = 0; d0 < NDV; ++d0) { s16x4 lo[4], hi[4];
#pragma unroll
        for (int ks = 0; ks < 4; ++ks) {
            asm volatile("ds_read_b64_tr_b16 %0,%1 offset:%c2" : "=&v"(lo[ks]) : "v"(vb[d0]), "i"(ks * 16 * RS) : "memory");
            asm volatile("ds_read_b64_tr_b16 %0,%1 offset:%c2" : "=&v"(hi[ks]) : "v"(vb[d0]), "i"(ks * 16 * RS + 8 * RS) : "memory"); }
        asm volatile("s_waitcnt lgkmcnt(0)" ::: "memory"); ATT_SBAR();
#define ATT_PK(k) (bf16x8){lo[k][0], lo[k][1], lo[k][2], lo[k][3], hi[k][0], hi[k][1], hi[k][2], hi[k][3]}
        o[d0] = __builtin_amdgcn_mfma_f32_32x32x16_bf16(pa0, ATT_PK(0), o[d0], 0, 0, 0);
        o[d0] = __builtin_amdgcn_mfma_f32_32x32x16_bf16(pa1, ATT_PK(1), o[d0], 0, 0, 0);
        o[d0] = __builtin_amdgcn_mfma_f32_32x32x16_bf16(pa2, ATT_PK(2), o[d0], 0, 0, 0);
        o[d0] = __builtin_amdgcn_mfma_f32_32x32x16_bf16(pa3, ATT_PK(3), o[d0], 0, 0, 0);
#undef ATT_PK
    }
}
template <int NDV> __device__ __forceinline__ void softmax_step(f32x16& p0, f32x16& p1, float& m, float& l, f32x16* o, ATT_LAS float* wsf, int r32, int hi, u32x4& pw0, u32x4& pw1, u32x4& pw2, u32x4& pw3) {
    const float rm = rowmax(p0, p1);
    const float mn = fmaxf(m, rm);
    if (__any(mn > m)) {
        const float alpha = __builtin_amdgcn_exp2f(m - mn);
        l *= alpha;
        if (hi == 0) wsf[r32] = alpha;
        asm volatile("s_waitcnt lgkmcnt(0)" ::: "memory");
        float al[16];
#pragma unroll
        for (int r = 0; r < 16; ++r) al[r] = wsf[crow(r, hi)];
#pragma unroll
        for (int d = 0; d < NDV; ++d)
#pragma unroll
            for (int r = 0; r < 16; ++r) o[d][r] *= al[r];
        m = mn;
    }
    float s = 0.f;
#pragma unroll
    for (int r = 0; r < 16; ++r) { p0[r] = __builtin_amdgcn_exp2f(p0[r] - m); p1[r] = __builtin_amdgcn_exp2f(p1[r] - m); s += p0[r] + p1[r]; }
    l += s;
    pw0 = (u32x4){cvtpk(p0[0], p0[1]), cvtpk(p0[2], p0[3]), cvtpk(p0[4], p0[5]), cvtpk(p0[6], p0[7])};
    pw1 = (u32x4){cvtpk(p0[8], p0[9]), cvtpk(p0[10], p0[11]), cvtpk(p0[12], p0[13]), cvtpk(p0[14], p0[15])};
    pw2 = (u32x4){cvtpk(p1[0], p1[1]), cvtpk(p1[2], p1[3]), cvtpk(p1[4], p1[5]), cvtpk(p1[6], p1[7])};
    pw3 = (u32x4){cvtpk(p1[8], p1[9]), cvtpk(p1[10], p1[11]), cvtpk(p1[12], p1[13]), cvtpk(p1[14], p1[15])};
}

constexpr int A_K = 0, A_V = 16384, A_WS = 32768, A_OST = A_WS + 2048, A_BIAS = A_OST + 32768, A_POSK = A_BIAS + 1280, A_TMAX = A_POSK + 3072, A_TMIN = A_TMAX + 64, A_BYTES = A_TMIN + 64;
__device__ __forceinline__ void attn_a_unit(int b, int h, int u, const bf16_t* Q, const bf16_t* K, const bf16_t* V, const bf16_t* G, bf16_t* O, const int* pos, const float* relb, lds_u8* shm) {
    const int tid = threadIdx.x, lane = tid & 63, r32 = lane & 31, hi = lane >> 5; const int wid = __builtin_amdgcn_readfirstlane(tid >> 6);
    const long rowbase = (long)b * SEQ; const int q0 = u * 256;
    const int c0 = 4 * u, kc_lo = (c0 - PAST) > 0 ? (c0 - PAST) : 0, NT = c0 + 3 - kc_lo + 1;
    const int cw = c0 + (wid >> 1); const int t_lo = ((cw - PAST) > 0 ? (cw - PAST) : 0) - kc_lo, t_hi = cw - kc_lo;
    ATT_LAS float* wsf = (ATT_LAS float*)(shm + A_WS) + wid * 64;
    ATT_LAS float* bias2 = (ATT_LAS float*)(shm + A_BIAS);
    ATT_LAS int* posk = (ATT_LAS int*)(shm + A_POSK);
    ATT_LAS int* tmax = (ATT_LAS int*)(shm + A_TMAX); ATT_LAS int* tmin = (ATT_LAS int*)(shm + A_TMIN);
    const unsigned lds0 = (unsigned)(uintptr_t)shm;
    const bf16_t* Kh = K + (rowbase + (long)kc_lo * 64) * DM + h * 64; const bf16_t* Vh = V + (rowbase + (long)kc_lo * 64) * DM + h * 64;
    const int drow = 8 * wid + (lane >> 3), dpos = lane & 7;
    const bf16_t* ksrc = Kh + (long)drow * DM + ((dpos ^ ((drow >> 1) & 7)) * 8);
    const bf16_t* vsrc = Vh + (long)drow * DM + ((dpos ^ (((drow >> 1) & 1) << 2)) * 8);
    const unsigned kdst = lds0 + A_K + wid * 1024, vdst = lds0 + A_V + wid * 1024;
    int koff[4];
#pragma unroll
    for (int d0 = 0; d0 < 4; ++d0) koff[d0] = r32 * 128 + (((2 * d0 + hi) ^ ((r32 >> 1) & 7)) << 4);
#define A_DMA(t, slot) do { glds16(ksrc + (long)(t) * 64 * DM, (unsigned)__builtin_amdgcn_readfirstlane(kdst + (slot) * 8192)); glds16(vsrc + (long)(t) * 64 * DM, (unsigned)__builtin_amdgcn_readfirstlane(vdst + (slot) * 8192)); } while (0)
    A_DMA(0, 0);
    if (tid < NREL) bias2[tid] = relb[h * NREL + tid] * LOG2E;
    for (int i = tid; i < NT * 64; i += 512) posk[i] = pos[rowbase + kc_lo * 64 + i];
    asm volatile("s_waitcnt lgkmcnt(0)\n\ts_barrier" ::: "memory");
    for (int t = wid; t < NT; t += 8) { int v = posk[t * 64 + lane]; int mx = v, mn = v;
#pragma unroll
        for (int o_ = 1; o_ < 64; o_ <<= 1) { mx = max(mx, __shfl_xor(mx, o_)); mn = min(mn, __shfl_xor(mn, o_)); }
        if (lane == 0) { tmax[t] = mx; tmin[t] = mn; } }
    const bf16_t* Qw = Q + (rowbase + q0 + wid * 32) * DM + h * 64;
    bf16x8 qr[4];
#pragma unroll
    for (int d0 = 0; d0 < 4; ++d0) qr[d0] = *reinterpret_cast<const bf16x8*>(&Qw[(long)r32 * DM + d0 * 16 + hi * 8]);
    const int qpos = pos[rowbase + q0 + wid * 32 + r32];
    float m = -1e30f, l = 0.f; f32x16 o[2]; o[0] = f32x16{}; o[1] = f32x16{};
    int vb0[2]; { const int q_ = (lane & 15) >> 2, xq = (q_ >> 1) & 1;
        const int base = (int)(lds0 + A_V) + (4 * hi + q_) * 128 + ((lane >> 4) & 1) * 32 + (lane & 3) * 8;
        vb0[0] = base + xq * 64; vb0[1] = base + (xq ^ 1) * 64; }
    for (int t = 0; t < NT; ++t) {
        ATT_WAIT_BAR(0);
        if (t + 1 < NT) A_DMA(t + 1, (t + 1) & 1);
        if (t >= t_lo && t <= t_hi) {
            const int slot = t & 1;
            f32x16 p0, p1; u32x4 pw0, pw1, pw2, pw3;
            qkt(p0, p1, (lds_cptr)(shm + A_K + slot * 8192), qr, koff);
            const int kmx = tmax[t], kmn = tmin[t];
            if (__all(qpos - kmx >= MAXREL)) { const float bb = bias2[2 * MAXREL];
#pragma unroll
                for (int r = 0; r < 16; ++r) { p0[r] += bb; p1[r] += bb; } }
            else if (__all(qpos - kmn <= -MAXREL)) { const float bb = bias2[0];
#pragma unroll
                for (int r = 0; r < 16; ++r) { p0[r] += bb; p1[r] += bb; } }
            else {
#pragma unroll
                for (int r = 0; r < 16; ++r) { const int kk = t * 64 + crow(r, hi);
                    int r0 = qpos - posk[kk], r1 = qpos - posk[kk + 32];
                    r0 = min(max(r0, -MAXREL), MAXREL) + MAXREL; r1 = min(max(r1, -MAXREL), MAXREL) + MAXREL;
                    p0[r] += bias2[r0]; p1[r] += bias2[r1]; } }
            softmax_step<2>(p0, p1, m, l, o, wsf, r32, hi, pw0, pw1, pw2, pw3);
            ATT_SBAR();
            const int vbs[2] = {vb0[0] + slot * 8192, vb0[1] + slot * 8192};
            pv<2>(o, vbs, __builtin_bit_cast(bf16x8, pw0), __builtin_bit_cast(bf16x8, pw1), __builtin_bit_cast(bf16x8, pw2), __builtin_bit_cast(bf16x8, pw3));
        }
    }
#undef A_DMA
    { auto rr = __builtin_amdgcn_permlane32_swap(__float_as_uint(l), __float_as_uint(l), false, false); l = __uint_as_float(rr[0]) + __uint_as_float(rr[1]); }
    if (hi == 0) wsf[32 + r32] = l; asm volatile("s_waitcnt lgkmcnt(0)" ::: "memory");
    float rli[16];
#pragma unroll
    for (int r = 0; r < 16; ++r) rli[r] = __builtin_amdgcn_rcpf(wsf[32 + crow(r, hi)]);
    { ATT_LAS bf16_t* stg = (ATT_LAS bf16_t*)(shm + A_OST) + wid * 2048;
#pragma unroll
        for (int r = 0; r < 16; ++r) { const int orow = crow(r, hi);
#pragma unroll
            for (int d0 = 0; d0 < 2; ++d0) stg[orow * 64 + d0 * 32 + r32] = f2bf(o[d0][r] * rli[r]); }
        asm volatile("s_waitcnt lgkmcnt(0)" ::: "memory");
        const long orow0 = rowbase + q0 + wid * 32;
#pragma unroll
        for (int i = 0; i < 4; ++i) { const int row = i * 8 + (lane >> 3), ch = lane & 7;
            const u32x4 v = *(const ATT_LAS u32x4*)(stg + row * 64 + ch * 8);
            const u32x4 g = *(const u32x4*)(G + (orow0 + row) * DM + h * 64 + ch * 8);
            u32x4 w;
#pragma unroll
            for (int e = 0; e < 4; ++e) { const float v0 = __uint_as_float(v[e] << 16), v1 = __uint_as_float(v[e] & 0xffff0000u), g0 = __uint_as_float(g[e] << 16), g1 = __uint_as_float(g[e] & 0xffff0000u);
                w[e] = cvtpk(v0 * silu(g0), v1 * silu(g1)); }
            *(u32x4*)(O + (orow0 + row) * DM + h * 64 + ch * 8) = w; } }
    asm volatile("s_waitcnt lgkmcnt(0)\n\ts_barrier" ::: "memory");
}

constexpr int B_RING = 0, B_SLOT = 32768, B_WS = 65536, B_OST = B_WS + 2048, B_BYTES = B_OST + 32768;
__device__ __forceinline__ void attn_b_unit(int b, int h, int qb, const bf16_t* Q, const bf16_t* K, const bf16_t* V, const bf16_t* G, bf16_t* O, const float* subln, float lam, lds_u8* shm) {
    const int tid = threadIdx.x, lane = tid & 63, r32 = lane & 31, hi = lane >> 5; const int wid = __builtin_amdgcn_readfirstlane(tid >> 6);
    const int map = wid >> 2, wq = wid & 3;
    const long rowbase = (long)b * SEQ; const int q0 = qb * 128;
    const int NT = 2 * qb + 2; const int t_hi = 2 * qb + (wq >> 1);
    ATT_LAS float* wsf = (ATT_LAS float*)(shm + B_WS) + wid * 64;
    const unsigned lds0 = (unsigned)(uintptr_t)shm;
    const bf16_t* Kh = K + rowbase * DM + h * 128; const bf16_t* Vh = V + rowbase * DM + h * 128;
    const int drow = 8 * wid + (lane >> 3), dpos = lane & 7;
    const bf16_t* k0src = Kh + (long)drow * DM + ((dpos ^ ((drow >> 1) & 7)) * 8);
    const bf16_t* k1src = k0src + 64;
    const int vrow = 4 * wid + (lane >> 4), vpos = lane & 15;
    const bf16_t* v0src = Vh + (long)vrow * DM + ((vpos ^ ((vrow & 3) << 2)) * 8);
    const bf16_t* v1src = v0src + (long)32 * DM;
    const unsigned k0dst = lds0 + B_RING + wid * 1024, k1dst = k0dst + 8192, v0dst = lds0 + B_RING + 16384 + wid * 1024, v1dst = v0dst + 8192;
    int koff[4];
#pragma unroll
    for (int d0 = 0; d0 < 4; ++d0) koff[d0] = r32 * 128 + (((2 * d0 + hi) ^ ((r32 >> 1) & 7)) << 4);
#define B_DMA(t, slot) do { const long go_ = (long)(t) * 64 * DM; const unsigned so_ = (slot) * B_SLOT; \
        glds16(k0src + go_, (unsigned)__builtin_amdgcn_readfirstlane(k0dst + so_)); glds16(k1src + go_, (unsigned)__builtin_amdgcn_readfirstlane(k1dst + so_)); \
        glds16(v0src + go_, (unsigned)__builtin_amdgcn_readfirstlane(v0dst + so_)); glds16(v1src + go_, (unsigned)__builtin_amdgcn_readfirstlane(v1dst + so_)); } while (0)
    B_DMA(0, 0);
    const bf16_t* Qw = Q + (rowbase + q0 + wq * 32) * DM + h * 128 + map * 64;
    bf16x8 qr[4];
#pragma unroll
    for (int d0 = 0; d0 < 4; ++d0) qr[d0] = *reinterpret_cast<const bf16x8*>(&Qw[(long)r32 * DM + d0 * 16 + hi * 8]);
    float m = -1e30f, l = 0.f; f32x16 o[4];
#pragma unroll
    for (int d = 0; d < 4; ++d) o[d] = f32x16{};
    int vb0[4]; { const int q_ = (lane & 15) >> 2;
        const int base = (int)(lds0 + B_RING + 16384) + (4 * hi + q_) * 256 + ((lane >> 4) & 1) * 32 + (lane & 3) * 8;
#pragma unroll
        for (int d0 = 0; d0 < 4; ++d0) vb0[d0] = base + ((d0 ^ q_) * 64); }
    for (int t = 0; t < NT; ++t) {
        ATT_WAIT_BAR(0);
        if (t + 1 < NT) B_DMA(t + 1, (t + 1) & 1);
        if (t <= t_hi) {
            const int slot = t & 1;
            f32x16 p0, p1; u32x4 pw0, pw1, pw2, pw3;
            qkt(p0, p1, (lds_cptr)(shm + B_RING + slot * B_SLOT + map * 8192), qr, koff);
            softmax_step<4>(p0, p1, m, l, o, wsf, r32, hi, pw0, pw1, pw2, pw3);
            ATT_SBAR();
            const int vbs[4] = {vb0[0] + slot * B_SLOT, vb0[1] + slot * B_SLOT, vb0[2] + slot * B_SLOT, vb0[3] + slot * B_SLOT};
            pv<4>(o, vbs, __builtin_bit_cast(bf16x8, pw0), __builtin_bit_cast(bf16x8, pw1), __builtin_bit_cast(bf16x8, pw2), __builtin_bit_cast(bf16x8, pw3));
        }
    }
#undef B_DMA
    { auto rr = __builtin_amdgcn_permlane32_swap(__float_as_uint(l), __float_as_uint(l), false, false); l = __uint_as_float(rr[0]) + __uint_as_float(rr[1]); }
    if (hi == 0) wsf[32 + r32] = l; asm volatile("s_waitcnt lgkmcnt(0)" ::: "memory");
    float rli[16];
#pragma unroll
    for (int r = 0; r < 16; ++r) rli[r] = __builtin_amdgcn_rcpf(wsf[32 + crow(r, hi)]);
    asm volatile("s_waitcnt lgkmcnt(0)\n\ts_barrier" ::: "memory");
    ATT_LAS float* X = (ATT_LAS float*)(shm + B_RING) + wq * 4096;
    if (map == 1) {
#pragma unroll
        for (int d = 0; d < 4; ++d)
#pragma unroll
            for (int r = 0; r < 16; ++r) X[(d * 16 + r) * 64 + lane] = o[d][r] * rli[r] * lam;
    }
    asm volatile("s_waitcnt lgkmcnt(0)\n\ts_barrier" ::: "memory");
    if (map == 0) {
        float ss[16];
#pragma unroll
        for (int r = 0; r < 16; ++r) ss[r] = 0.f;
#pragma unroll
        for (int d = 0; d < 4; ++d)
#pragma unroll
            for (int r = 0; r < 16; ++r) { const float v = o[d][r] * rli[r] - X[(d * 16 + r) * 64 + lane]; o[d][r] = v; ss[r] += v * v; }
#pragma unroll
        for (int r = 0; r < 16; ++r) {
#pragma unroll
            for (int o_ = 1; o_ < 32; o_ <<= 1) ss[r] += __shfl_xor(ss[r], o_);
            ss[r] = rsqrtf(ss[r] * (1.f / 128.f) + EPS) * (1.f - LAM_INIT); }
        ATT_LAS bf16_t* stg = (ATT_LAS bf16_t*)(shm + B_OST) + wq * 4096;
#pragma unroll
        for (int r = 0; r < 16; ++r) { const int orow = crow(r, hi);
#pragma unroll
            for (int d = 0; d < 4; ++d) stg[orow * 128 + d * 32 + r32] = f2bf(o[d][r] * ss[r]); }
        asm volatile("s_waitcnt lgkmcnt(0)" ::: "memory");
        const long orow0 = rowbase + q0 + wq * 32;
#pragma unroll
        for (int i = 0; i < 8; ++i) { const int row = i * 4 + (lane >> 4), ch = lane & 15;
            const u32x4 v = *(const ATT_LAS u32x4*)(stg + row * 128 + ch * 8);
            const u32x4 g = *(const u32x4*)(G + (orow0 + row) * DM + h * 128 + ch * 8);
            const f32x4 sa = *(const f32x4*)(subln + ch * 8), sb = *(const f32x4*)(subln + ch * 8 + 4);
            const float sl[8] = {sa[0], sa[1], sa[2], sa[3], sb[0], sb[1], sb[2], sb[3]};
            u32x4 w;
#pragma unroll
            for (int e = 0; e < 4; ++e) { const float v0 = __uint_as_float(v[e] << 16), v1 = __uint_as_float(v[e] & 0xffff0000u), g0 = __uint_as_float(g[e] << 16), g1 = __uint_as_float(g[e] & 0xffff0000u);
                w[e] = cvtpk(v0 * sl[2 * e] * silu(g0), v1 * sl[2 * e + 1] * silu(g1)); }
            *(u32x4*)(O + (orow0 + row) * DM + h * 128 + ch * 8) = w; }
    }
    asm volatile("s_waitcnt lgkmcnt(0)\n\ts_barrier" ::: "memory");
}
#undef ATT_SBAR
#undef ATT_WAIT_BAR
}
constexpr int NWAVES = 8;
constexpr size_t MiB = 1u << 20;
constexpr size_t WS_CTL = 0, CTL_ZERO_BYTES = 1 * MiB;
constexpr size_t WS_WIN_A = 2 * MiB, WS_WOUT_A = 10 * MiB, WS_WCAT = 12 * MiB, WS_WOUT_B = 20 * MiB, WS_CS = 22 * MiB;
constexpr size_t WS_XN = 32 * MiB, WS_S0 = 96 * MiB, WS_S1 = 160 * MiB, WS_S2 = 224 * MiB, WS_S3 = 288 * MiB, WS_Y = 352 * MiB, WS_END = 480 * MiB;
constexpr size_t SPL = (size_t)T * DM;
constexpr int CW_TMO = 0, CW_CODE = 1, CW_BAR = 4096;
constexpr int N_BAR_REGIONS = 3;
constexpr int RING_OFF = 0, RING_BYTES = 131072;
constexpr int LDSCTL_OFF = RING_BYTES, MISC_OFF = LDSCTL_OFF + 320;
constexpr int LDS_BYTES = 147456;

#define GAS __attribute__((address_space(1)))
#define LAS __attribute__((address_space(3)))
typedef unsigned v4u __attribute__((ext_vector_type(4)));
typedef float f32x4 __attribute__((ext_vector_type(4)));
typedef short bf16x8 __attribute__((ext_vector_type(8)));
typedef GAS unsigned gu32;
#define RLX_AGENT __ATOMIC_RELAXED, __HIP_MEMORY_SCOPE_AGENT
#define LDS_WAIT() asm volatile("s_waitcnt lgkmcnt(0)" ::: "memory")
#define VM_WAIT() asm volatile("s_waitcnt vmcnt(0)" ::: "memory")
__device__ __forceinline__ unsigned pk2(float lo, float hi) { return (unsigned)f2bf(lo) | ((unsigned)f2bf(hi) << 16); }
__device__ __forceinline__ float wave_sum(float v) {
#pragma unroll
    for (int o = 1; o < 64; o <<= 1) v += __shfl_xor(v, o);
    return v;
}
#define XB_TMO      128
#define XB_XCNT(j)  (256  + 64 * (j))
#define XB_XSUB(j)  (1280 + 64 * (j))
#define XB_XGEN(j)  (2304 + 64 * (j))
#define XB_TOP      3328
#define XB_TOPGEN   3392
#define XCD_BAR_WORDS 3456
#define XB_SPIN_CAP (1u << 18)

__device__ __forceinline__ unsigned xb_ld(unsigned* p)              { return __hip_atomic_load(p, __ATOMIC_RELAXED, __HIP_MEMORY_SCOPE_AGENT); }
__device__ __forceinline__ unsigned xb_add(unsigned* p, unsigned v) { return __hip_atomic_fetch_add(p, v, __ATOMIC_RELAXED, __HIP_MEMORY_SCOPE_AGENT); }
__device__ __forceinline__ unsigned xb_xcc_id() { return (unsigned)__builtin_amdgcn_s_getreg((3 << 11) | 20) & 0xFu; }
#define XB_SPIN(cond, bar) do { unsigned _sp = 0; while (cond) { __builtin_amdgcn_s_sleep(1); \
    if ((++_sp & 255u) == 0u) { if (xb_ld(&(bar)[XB_TMO])) break; if (_sp > XB_SPIN_CAP) { atomicAdd(&(bar)[XB_TMO], 1u); break; } } } } while (0)

struct XcdBarrier {
    unsigned* bar; unsigned x;
    volatile LAS unsigned* st;
};

__device__ __forceinline__ XcdBarrier xcd_barrier_post(unsigned* bar, volatile LAS unsigned* st) {
    XcdBarrier b; b.bar = bar; b.x = xb_xcc_id(); b.st = st;
    if (threadIdx.x == 0) (void)xb_add(&bar[XB_XCNT(b.x)], 1u);
    return b;
}
__device__ __forceinline__ void xcd_barrier_complete(unsigned* bar, unsigned x, unsigned& nloc, unsigned& nx) {
    const unsigned G = gridDim.x * gridDim.y * gridDim.z;
    unsigned sum, cnt, mine, sp = 0u;
    for (;;) {
        sum = 0u; cnt = 0u; mine = 0u;
#pragma unroll
        for (unsigned j = 0; j < 16; ++j) { const unsigned c = xb_ld(&bar[XB_XCNT(j)]); sum += c; cnt += (c > 0u) ? 1u : 0u; mine = (j == x) ? c : mine; }
        if (sum == G) break;
        __builtin_amdgcn_s_sleep(1);
        if ((++sp & 255u) == 0u) { if (xb_ld(&bar[XB_TMO])) break; if (sp > XB_SPIN_CAP) { atomicAdd(&bar[XB_TMO], 1u); break; } }
    }
    nloc = mine > 0u ? mine : 1u; nx = cnt > 0u ? cnt : 1u;
}

__device__ __forceinline__ void xcd_barrier(const XcdBarrier& b) {
    asm volatile("s_waitcnt vmcnt(0)" ::: "memory");
    __syncthreads();
    if (threadIdx.x == 0) {
        unsigned* bar = b.bar;
        __builtin_amdgcn_s_waitcnt(0);
        unsigned nloc = b.st[0], nx = b.st[1];
        if (nloc == 0u) { xcd_barrier_complete(bar, b.x, nloc, nx); b.st[0] = nloc; b.st[1] = nx; }
        const unsigned old = xb_add(&bar[XB_XSUB(b.x)], 1u);
        const unsigned gen = old / nloc;
        if (old + 1u == (gen + 1u) * nloc) {
            __builtin_amdgcn_fence(__ATOMIC_RELEASE, "agent");
            asm volatile("s_waitcnt vmcnt(0)" ::: "memory");
            const unsigned og = xb_add(&bar[XB_TOP], 1u);
            const unsigned tg = og / nx;
            if (og + 1u == (tg + 1u) * nx) xb_add(&bar[XB_TOPGEN], 1u);
            else XB_SPIN(xb_ld(&bar[XB_TOPGEN]) == tg, bar);
            __builtin_amdgcn_fence(__ATOMIC_ACQUIRE, "agent");
            xb_add(&bar[XB_XGEN(b.x)], 1u);
            asm volatile("s_waitcnt vmcnt(0)" ::: "memory");
        } else {
            XB_SPIN(xb_ld(&bar[XB_XGEN(b.x)]) == gen, bar);
            __builtin_amdgcn_fence(__ATOMIC_ACQUIRE, "agent");
            asm volatile("s_waitcnt vmcnt(0)" ::: "memory");
        }
    }
    __syncthreads();
}
struct Frame {
    LAS unsigned char* lds;
    volatile LAS unsigned* MISC;
    gu32* ctl;
    int tid, lane, wave, vcu, G;
};

__device__ __forceinline__ void p0_transpose_item(const float* W, const float* g, int K, int N, bf16_t* WT, int row_off, LAS float* scr, int item, int lane) {
    const int nblk = N / 32, kb = item / nblk, nb = item % nblk, k0 = 64 * kb, n0 = 32 * nb;
#pragma unroll 8
    for (int i = 0; i < 32; ++i) { const int kk = 2 * i + (lane >> 5); const float gv = g ? g[k0 + kk] : 1.f; scr[kk * 33 + (lane & 31)] = W[(size_t)(k0 + kk) * N + n0 + (lane & 31)] * gv; }
    LDS_WAIT(); asm volatile("" ::: "memory");
    const int c = lane & 7;
#pragma unroll
    for (int j = 0; j < 4; ++j) { const int n = (lane >> 3) + 8 * j; const LAS float* s = scr + (8 * c) * 33 + n;
        v4u o; o.x = pk2(s[0 * 33], s[1 * 33]); o.y = pk2(s[2 * 33], s[3 * 33]); o.z = pk2(s[4 * 33], s[5 * 33]); o.w = pk2(s[6 * 33], s[7 * 33]);
        *(GAS v4u*)(WT + (size_t)(row_off + n0 + n) * K + k0 + 8 * c) = o; }
    LDS_WAIT(); asm volatile("" ::: "memory");
}
__device__ __forceinline__ void rms_row_to_bf16(int lane, const float* xrow, bf16_t* orow) {
    const GAS f32x4* xr = (const GAS f32x4*)xrow + lane;
    f32x4 v[4]; float s = 0.f;
#pragma unroll
    for (int j = 0; j < 4; ++j) { v[j] = xr[64 * j]; s += (v[j].x * v[j].x + v[j].y * v[j].y) + (v[j].z * v[j].z + v[j].w * v[j].w); }
    const float r = rsqrtf(wave_sum(s) * (1.f / DM) + EPS);
    GAS unsigned long long* o8 = (GAS unsigned long long*)orow + lane;
#pragma unroll
    for (int j = 0; j < 4; ++j) o8[64 * j] = (unsigned long long)pk2(v[j].x * r, v[j].y * r) | ((unsigned long long)pk2(v[j].z * r, v[j].w * r) << 32);
}
__device__ __forceinline__ void resnorm_row(int lane, const float* hin, const float* y, const float* g, float* hout, bf16_t* hn) {
    const GAS f32x4* yr = (const GAS f32x4*)y + lane; const GAS f32x4* hr = (const GAS f32x4*)hin + lane; const GAS f32x4* gr = (const GAS f32x4*)g + lane;
    f32x4 v[4], hv[4]; float s = 0.f;
#pragma unroll
    for (int j = 0; j < 4; ++j) { v[j] = yr[64 * j]; hv[j] = hr[64 * j]; s += (v[j].x * v[j].x + v[j].y * v[j].y) + (v[j].z * v[j].z + v[j].w * v[j].w); }
    const float r = rsqrtf(wave_sum(s) * (1.f / DM) + EPS);
    float s2 = 0.f;
    GAS f32x4* orow = (GAS f32x4*)hout + lane;
#pragma unroll
    for (int j = 0; j < 4; ++j) { v[j] = hv[j] + v[j] * r * gr[64 * j]; s2 += (v[j].x * v[j].x + v[j].y * v[j].y) + (v[j].z * v[j].z + v[j].w * v[j].w); orow[64 * j] = v[j]; }
    if (hn) {
        const float r2 = rsqrtf(wave_sum(s2) * (1.f / DM) + EPS);
        GAS unsigned long long* o8 = (GAS unsigned long long*)hn + lane;
#pragma unroll
        for (int j = 0; j < 4; ++j) o8[64 * j] = (unsigned long long)pk2(v[j].x * r2, v[j].y * r2) | ((unsigned long long)pk2(v[j].z * r2, v[j].w * r2) << 32);
    }
}

struct Args { const float* in[18]; float* out; unsigned char* ws; int ph_lo, ph_hi, li, pad; };

__global__ void __launch_bounds__(NWAVES * 64, 2) mega_fwd(Args args) {
    extern __shared__ __attribute__((aligned(16))) unsigned char lds[];
    Frame F;
    F.lds = (LAS unsigned char*)lds;
    F.MISC = (volatile LAS unsigned*)(F.lds + MISC_OFF);
    F.tid = threadIdx.x; F.lane = F.tid & 63; F.wave = __builtin_amdgcn_readfirstlane(F.tid >> 6);
    F.G = gridDim.x; { const int bx = blockIdx.x; F.vcu = (F.G % 8 == 0) ? (bx % 8) * (F.G / 8) + bx / 8 : bx; }
    unsigned char* ws = args.ws;
    F.ctl = (gu32*)(ws + WS_CTL);
    const float* x = args.in[0]; const int* pos = (const int*)args.in[1];
    const float* a_norm_pre = args.in[2]; const float* a_w_in = args.in[3]; const float* a_rel_bias = args.in[4];
    const float* a_w_out = args.in[5]; const float* a_norm_post = args.in[6]; const float* kv_norm = args.in[7];
    const float* kv_w = args.in[8]; const float* b_norm_pre = args.in[9]; const float* b_w_in = args.in[10];
    const float* lq1 = args.in[11]; const float* lk1 = args.in[12]; const float* lq2 = args.in[13]; const float* lk2 = args.in[14];
    const float* b_subln = args.in[15]; const float* b_w_out = args.in[16]; const float* b_norm_post = args.in[17];
    float* out = args.out;
    bf16_t* Wt_in_a = (bf16_t*)(ws + WS_WIN_A); bf16_t* Wt_out_a = (bf16_t*)(ws + WS_WOUT_A); bf16_t* Wt_cat = (bf16_t*)(ws + WS_WCAT); bf16_t* Wt_out_b = (bf16_t*)(ws + WS_WOUT_B);
    float* cs = (float*)(ws + WS_CS);
    bf16_t* XN = (bf16_t*)(ws + WS_XN); bf16_t* S0 = (bf16_t*)(ws + WS_S0); bf16_t* S2 = (bf16_t*)(ws + WS_S2);
    float* Y = (float*)(ws + WS_Y);
    bf16_t* S1 = (bf16_t*)(ws + WS_S1); bf16_t* S3 = (bf16_t*)(ws + WS_S3);

    for (int u = F.tid; u < (LDS_BYTES - LDSCTL_OFF) / 4; u += NWAVES * 64) ((LAS unsigned*)(F.lds + LDSCTL_OFF))[u] = 0u;
    __syncthreads();
    XcdBarrier bar = xcd_barrier_post((unsigned*)(F.ctl + CW_BAR) + args.li * XCD_BAR_WORDS, F.MISC + 8);
    const int lo = args.ph_lo, hi = args.ph_hi;
#define IN(k) (lo <= (k) && (k) < hi)
#define BOTH(k) (IN(k) && IN((k) + 1))
    const int gw = F.vcu * NWAVES + F.wave, NGW = F.G * NWAVES;

    if (IN(0)) for (int rep_ = 0; rep_ < (DUP == 0 ? 2 : 1); ++rep_) {
        LAS float* scr = (LAS float*)(F.lds + RING_OFF + F.wave * 16384);
        constexpr int I_IN = 16 * 128, I_OUT = 16 * 32, I_KV = 16 * 64;
        constexpr int NITEMS = I_IN + I_OUT + 2 * I_KV + I_OUT;
        for (int it = gw; it < NITEMS; it += NGW) {
            int r = it;
            if (r < I_IN) { p0_transpose_item(a_w_in, a_norm_pre, 1024, 4096, Wt_in_a, 0, scr, r, F.lane); continue; } r -= I_IN;
            if (r < I_OUT) { p0_transpose_item(a_w_out, nullptr, 1024, 1024, Wt_out_a, 0, scr, r, F.lane); continue; } r -= I_OUT;
            if (r < I_KV) { p0_transpose_item(kv_w, kv_norm, 1024, 2048, Wt_cat, 0, scr, r, F.lane); continue; } r -= I_KV;
            if (r < I_KV) { p0_transpose_item(b_w_in, b_norm_pre, 1024, 2048, Wt_cat, 2048, scr, r, F.lane); continue; } r -= I_KV;
            p0_transpose_item(b_w_out, nullptr, 1024, 1024, Wt_out_b, 0, scr, r, F.lane);
        }
        for (int m = gw; m < T; m += NGW) rms_row_to_bf16(F.lane, x + (size_t)m * DM, XN + (size_t)m * DM);
        for (int idx = blockIdx.x * 512 + F.tid; idx < T * 8; idx += F.G * 512) {
            const int t = idx >> 3, i = idx & 7;
            const float inv = powf(500000.0f, -(float)i * 0.125f);
            const float ang = (float)pos[t] * inv;
            cs[t * 16 + i] = cosf(ang); cs[t * 16 + 8 + i] = sinf(ang);
        }
    }
    if (BOTH(0)) xcd_barrier(bar);
    if (IN(1)) for (int rep_ = 0; rep_ < (DUP == 1 ? 2 : 1); ++rep_) {
        pg8::Gemm g{XN, Wt_in_a, T, 4096, 1024}; pg8::StaticOrder S; S.init(T, 4096, F.G, (int)blockIdx.x);
        pg8::EpiSplit E{S0, SPL, 0, C2, 0u, cs};
        pg8::gemm_phase<pg8::EpiSplit, pg8::StaticOrder, true, true>(F.lds + RING_OFF, g, S, E);
    }
    if (BOTH(1)) xcd_barrier(bar);
    if (IN(2)) for (int rep_ = 0; rep_ < (DUP == 2 ? 2 : 1); ++rep_) {
        bf16_t* OGA = (DUP == 2 && rep_ == 0) ? XN : S0;
        for (int bh = F.vcu; bh < BATCH * 16; bh += F.G)
            for (int u = 0; u < 8; ++u) att::attn_a_unit(bh >> 4, bh & 15, u, S0, S1, S2, S3, OGA, pos, a_rel_bias, (att::lds_u8*)(F.lds + RING_OFF));
    }
    if (BOTH(2)) xcd_barrier(bar);
    if (IN(3)) for (int rep_ = 0; rep_ < (DUP == 3 ? 2 : 1); ++rep_) {
        pg8::Gemm g{S0, Wt_out_a, T, 1024, 1024}; pg8::StaticOrder S; S.init(T, 1024, F.G, (int)blockIdx.x);
        pg8::EpiF32 E{Y, 1024};
        pg8::gemm_phase<pg8::EpiF32, pg8::StaticOrder, true, true>(F.lds + RING_OFF, g, S, E);
    }
    if (BOTH(3)) xcd_barrier(bar);
    if (IN(4)) for (int rep_ = 0; rep_ < (DUP == 4 ? 2 : 1); ++rep_) {
        for (int m = gw; m < T; m += NGW) resnorm_row(F.lane, x + (size_t)m * DM, Y + (size_t)m * DM, a_norm_post, out + (size_t)m * DM, XN + (size_t)m * DM);
    }
    if (BOTH(4)) xcd_barrier(bar);
    if (IN(5)) for (int rep_ = 0; rep_ < (DUP == 5 ? 2 : 1); ++rep_) {
        pg8::Gemm g{XN, Wt_cat, T, 4096, 1024}; pg8::StaticOrder S; S.init(T, 4096, F.G, (int)blockIdx.x);
        pg8::EpiSplit E{S0, SPL, 2, C2, 0x5u, cs};
        pg8::gemm_phase<pg8::EpiSplit, pg8::StaticOrder, true, true>(F.lds + RING_OFF, g, S, E);
    }
    if (BOTH(5)) xcd_barrier(bar);
    if (IN(6)) for (int rep_ = 0; rep_ < (DUP == 6 ? 2 : 1); ++rep_) {
        bf16_t* OGB = (DUP == 6 && rep_ == 0) ? (bf16_t*)Y : S2;
        float lam; { float a = lq1[F.lane] * lk1[F.lane], c = lq2[F.lane] * lk2[F.lane]; a = wave_sum(a); c = wave_sum(c); lam = __expf(a) - __expf(c) + LAM_INIT; }
        for (int v = F.vcu; v < BATCH * 8 * 2; v += F.G) { const int bh = v >> 1, s = v & 1;
            for (int j = 0; j < 8; ++j) { const int base = 2 * (j >> 1) + s, qb = (j & 1) ? 15 - base : base;
                att::attn_b_unit(bh >> 3, bh & 7, qb, S2, S0, S1, S3, OGB, b_subln, lam, (att::lds_u8*)(F.lds + RING_OFF)); } }
    }
    if (BOTH(6)) xcd_barrier(bar);
    if (IN(7)) for (int rep_ = 0; rep_ < (DUP == 7 ? 2 : 1); ++rep_) {
        pg8::Gemm g{S2, Wt_out_b, T, 1024, 1024}; pg8::StaticOrder S; S.init(T, 1024, F.G, (int)blockIdx.x);
        pg8::EpiF32 E{Y, 1024};
        pg8::gemm_phase<pg8::EpiF32, pg8::StaticOrder, true, true>(F.lds + RING_OFF, g, S, E);
    }
    if (BOTH(7)) xcd_barrier(bar);
    if (IN(8)) for (int rep_ = 0; rep_ < (DUP == 8 ? 2 : 1); ++rep_) {
        float* OUT8 = (DUP == 8 && rep_ == 0) ? (float*)S0 : out;
        for (int m = gw; m < T; m += NGW) resnorm_row(F.lane, out + (size_t)m * DM, Y + (size_t)m * DM, b_norm_post, OUT8 + (size_t)m * DM, nullptr);
    }
#undef IN
#undef BOTH
}

extern "C" void kernel_launch(void* const* d_in, const int* in_sizes, int n_in, void* d_out, int out_size, void* d_ws, size_t ws_size, hipStream_t stream) {
    static int grid = 0;
    if (grid == 0) {
        if (n_in != 18 || out_size != T * DM || ws_size < WS_END) { fprintf(stderr, "kernel_launch: unexpected shapes (n_in %d out %d ws %zu)\n", n_in, out_size, ws_size); grid = -1; return; }
        int dev = 0, cus = 0;
        if (hipGetDevice(&dev) != hipSuccess || hipDeviceGetAttribute(&cus, hipDeviceAttributeMultiprocessorCount, dev) != hipSuccess) { grid = -1; return; }
        if (hipFuncSetAttribute((const void*)mega_fwd, hipFuncAttributeMaxDynamicSharedMemorySize, LDS_BYTES) != hipSuccess) { fprintf(stderr, "kernel_launch: hipFuncSetAttribute failed\n"); grid = -1; return; }
        grid = cus;
    }
    if (grid < 0) return;
    (void)hipMemsetAsync((char*)d_ws + WS_CTL, 0, CTL_ZERO_BYTES, stream);
    Args a{};
    for (int i = 0; i < 18; ++i) a.in[i] = (const float*)d_in[i];
    a.out = (float*)d_out; a.ws = (unsigned char*)d_ws;
    unsigned char* ws = (unsigned char*)d_ws; (void)ws;
    int lo = 0, li = 0;
#define MEGA(l_, h_) do { a.ph_lo = (l_); a.ph_hi = (h_); a.li = li++; hipLaunchKernelGGL(mega_fwd, dim3(grid), dim3(NWAVES * 64), LDS_BYTES, stream, a); } while (0)
#if HYBRID & 1
    { bf16_t* S0 = (bf16_t*)(ws + WS_S0); bf16_t* S1 = (bf16_t*)(ws + WS_S1); bf16_t* S2 = (bf16_t*)(ws + WS_S2); bf16_t* S3 = (bf16_t*)(ws + WS_S3);
      MEGA(lo, 2); attn_a_naive<<<T * 16 / 64, 64, 0, stream>>>(S0, S1, S2, S3, (const int*)d_in[1], (const float*)d_in[4], S0); lo = 3; }
#endif
#if HYBRID & 2
    { bf16_t* S0 = (bf16_t*)(ws + WS_S0); bf16_t* S1 = (bf16_t*)(ws + WS_S1); bf16_t* S2 = (bf16_t*)(ws + WS_S2); bf16_t* S3 = (bf16_t*)(ws + WS_S3);
      MEGA(lo, 6); attn_b_naive<<<T * 8 * 2 / 64, 64, 0, stream>>>(S2, S0, S1, S3, (const float*)d_in[11], (const float*)d_in[12], (const float*)d_in[13], (const float*)d_in[14], (const float*)d_in[15], S2); lo = 7; }
#endif
    MEGA(lo, 9);
#undef MEGA
}
```

```cpp
#include <hip/hip_runtime.h>
#include <cstdint>
#include <cstdio>

#ifndef HYBRID
#define HYBRID 0
#endif

#ifndef DUP
#define DUP (-1)
#endif

typedef unsigned short bf16_t;
constexpr int BATCH = 16, SEQ = 2048, DM = 1024, T = BATCH * SEQ;
constexpr int CHUNK = 64, PAST = 8, MAXREL = 128, NREL = 257;
constexpr float EPS = 1e-6f;
constexpr float LAM_INIT = 0.35550906759096924f;
constexpr float LOG2E = 1.4426950408889634f;
constexpr float C2 = 0.125f * LOG2E;

__device__ __forceinline__ float bf2f(bf16_t v) { return __uint_as_float((unsigned)v << 16); }
__device__ __forceinline__ bf16_t f2bf(float f) { unsigned u = __float_as_uint(f); return (bf16_t)((u + 0x7fffu + ((u >> 16) & 1u)) >> 16); }

#if HYBRID
__global__ void __launch_bounds__(64) attn_a_naive(const bf16_t* Q, const bf16_t* Kb, const bf16_t* Vb, const bf16_t* G, const int* pos, const float* relb, bf16_t* OG) {
    int gid = blockIdx.x * 64 + threadIdx.x;
    int q = gid & (SEQ - 1), h = (gid >> 11) & 15, b = gid >> 15;
    int c = q >> 6;
    size_t trow = (size_t)b * SEQ + q;
    float qv[64];
#pragma unroll
    for (int d = 0; d < 64; ++d) qv[d] = bf2f(Q[trow * DM + h * 64 + d]);
    int qpos = pos[trow];
    const float* rb = relb + h * NREL;
    int kstart = (c - PAST) * CHUNK; if (kstart < 0) kstart = 0;
    int kend = (c + 1) * CHUNK;
    float m = -1e30f, l = 0.f;
    for (int k = kstart; k < kend; ++k) {
        size_t krow = (size_t)b * SEQ + k;
        const uint4* kp = (const uint4*)(Kb + krow * DM + h * 64);
        float s = 0.f;
#pragma unroll
        for (int j = 0; j < 8; ++j) { uint4 w = kp[j]; unsigned ww[4] = {w.x, w.y, w.z, w.w};
#pragma unroll
            for (int e = 0; e < 4; ++e) { s += qv[j * 8 + 2 * e] * __uint_as_float(ww[e] << 16) + qv[j * 8 + 2 * e + 1] * __uint_as_float(ww[e] & 0xffff0000u); } }
        int rel = qpos - pos[krow]; rel = rel < -MAXREL ? -MAXREL : (rel > MAXREL ? MAXREL : rel);
        s = s + rb[rel + MAXREL] * LOG2E;
        float mn = fmaxf(m, s);
        l = l * exp2f(m - mn) + exp2f(s - mn); m = mn;
    }
    float o[64];
#pragma unroll
    for (int d = 0; d < 64; ++d) o[d] = 0.f;
    float il = 1.f / l;
    for (int k = kstart; k < kend; ++k) {
        size_t krow = (size_t)b * SEQ + k;
        const uint4* kp = (const uint4*)(Kb + krow * DM + h * 64);
        float s = 0.f;
#pragma unroll
        for (int j = 0; j < 8; ++j) { uint4 w = kp[j]; unsigned ww[4] = {w.x, w.y, w.z, w.w};
#pragma unroll
            for (int e = 0; e < 4; ++e) { s += qv[j * 8 + 2 * e] * __uint_as_float(ww[e] << 16) + qv[j * 8 + 2 * e + 1] * __uint_as_float(ww[e] & 0xffff0000u); } }
        int rel = qpos - pos[krow]; rel = rel < -MAXREL ? -MAXREL : (rel > MAXREL ? MAXREL : rel);
        s = s + rb[rel + MAXREL] * LOG2E;
        float p = exp2f(s - m) * il;
        const uint4* vp = (const uint4*)(Vb + krow * DM + h * 64);
#pragma unroll
        for (int j = 0; j < 8; ++j) { uint4 w = vp[j]; unsigned ww[4] = {w.x, w.y, w.z, w.w};
#pragma unroll
            for (int e = 0; e < 4; ++e) { o[j * 8 + 2 * e] += p * __uint_as_float(ww[e] << 16); o[j * 8 + 2 * e + 1] += p * __uint_as_float(ww[e] & 0xffff0000u); } }
    }
#pragma unroll
    for (int d = 0; d < 64; ++d) {
        float g = bf2f(G[trow * DM + h * 64 + d]);
        float sg = g / (1.f + __expf(-g));
        OG[trow * DM + h * 64 + d] = f2bf(o[d] * sg);
    }
}

__global__ void __launch_bounds__(64) attn_b_naive(const bf16_t* Q, const bf16_t* Kb, const bf16_t* Vb, const bf16_t* G,
                                                   const float* lq1, const float* lk1, const float* lq2, const float* lk2, const float* subln, bf16_t* OG) {
    int gid = blockIdx.x * 64 + threadIdx.x;
    int m = gid & 1, rowid = gid >> 1;
    int q = rowid & (SEQ - 1), h = (rowid >> 11) & 7, b = rowid >> 14;
    float d1 = 0.f, d2 = 0.f;
    for (int i = 0; i < 64; ++i) { d1 += lq1[i] * lk1[i]; d2 += lq2[i] * lk2[i]; }
    float lam = __expf(d1) - __expf(d2) + LAM_INIT;
    size_t trow = (size_t)b * SEQ + q;
    float qv[64];
#pragma unroll
    for (int d = 0; d < 64; ++d) qv[d] = bf2f(Q[trow * DM + h * 128 + m * 64 + d]);
    int kend = ((q >> 6) + 1) * CHUNK;
    float mx = -1e30f, l = 0.f;
    for (int k = 0; k < kend; ++k) {
        size_t krow = (size_t)b * SEQ + k;
        const uint4* kp = (const uint4*)(Kb + krow * DM + h * 128 + m * 64);
        float s = 0.f;
#pragma unroll
        for (int j = 0; j < 8; ++j) { uint4 w = kp[j]; unsigned ww[4] = {w.x, w.y, w.z, w.w};
#pragma unroll
            for (int e = 0; e < 4; ++e) { s += qv[j * 8 + 2 * e] * __uint_as_float(ww[e] << 16) + qv[j * 8 + 2 * e + 1] * __uint_as_float(ww[e] & 0xffff0000u); } }
        float mn = fmaxf(mx, s);
        l = l * exp2f(mx - mn) + exp2f(s - mn); mx = mn;
    }
    float o[64];
#pragma unroll
    for (int d = 0; d < 64; ++d) o[d] = 0.f;
    float il = 1.f / l;
    for (int k = 0; k < kend; ++k) {
        size_t krow = (size_t)b * SEQ + k;
        const uint4* kp = (const uint4*)(Kb + krow * DM + h * 128 + m * 64);
        float s = 0.f;
#pragma unroll
        for (int j = 0; j < 8; ++j) { uint4 w = kp[j]; unsigned ww[4] = {w.x, w.y, w.z, w.w};
#pragma unroll
            for (int e = 0; e < 4; ++e) { s += qv[j * 8 + 2 * e] * __uint_as_float(ww[e] << 16) + qv[j * 8 + 2 * e + 1] * __uint_as_float(ww[e] & 0xffff0000u); } }
        float p = exp2f(s - mx) * il;
        float po = __shfl_xor(p, 1);
        float p0 = m ? po : p, p1 = m ? p : po;
        float a = p0 - lam * p1;
        const uint4* vp = (const uint4*)(Vb + krow * DM + h * 128 + m * 64);
#pragma unroll
        for (int j = 0; j < 8; ++j) { uint4 w = vp[j]; unsigned ww[4] = {w.x, w.y, w.z, w.w};
#pragma unroll
            for (int e = 0; e < 4; ++e) { o[j * 8 + 2 * e] += a * __uint_as_float(ww[e] << 16); o[j * 8 + 2 * e + 1] += a * __uint_as_float(ww[e] & 0xffff0000u); } }
    }
    float ss = 0.f;
#pragma unroll
    for (int d = 0; d < 64; ++d) ss += o[d] * o[d];
    ss += __shfl_xor(ss, 1);
    float r = rsqrtf(ss * (1.f / 128.f) + EPS) * (1.f - LAM_INIT);
#pragma unroll
    for (int d = 0; d < 64; ++d) {
        int c = h * 128 + m * 64 + d;
        float g = bf2f(G[trow * DM + c]);
        float sg = g / (1.f + __expf(-g));
        OG[trow * DM + c] = f2bf(o[d] * r * subln[m * 64 + d] * sg);
    }
}
#endif
namespace pg8 {
#define PG8_LAS __attribute__((address_space(3)))
typedef unsigned short bf16_t;
typedef short bf16x8 __attribute__((ext_vector_type(8)));
typedef float f32x4 __attribute__((ext_vector_type(4)));
typedef unsigned u32x4 __attribute__((ext_vector_type(4)));
constexpr int BM = 256, BK = 64, HALF = 128, HTB = HALF * BK * 2  , STAGE_BYTES = 8 * HTB, NXCD = 8, WGM = 8;

__host__ __device__ __forceinline__ int lds_byte(int r, int c) { const int st = (r >> 4) * 2 + (c >> 5), rr = r & 15, cc = c & 31, ob = rr * 64 + cc * 2; return st * 1024 + (ob ^ (((ob >> 9) & 1) << 5)); }
__host__ __device__ __forceinline__ void stage_rc(int b, int& R, int& C) { const int st = b / 1024, sb = b % 1024, swz = sb ^ (((sb >> 9) & 1) << 5); R = (st >> 1) * 16 + swz / 64; C = (st & 1) * 32 + (swz % 64) / 2; }
__host__ __device__ __forceinline__ int perm32(int rho) { const int n = rho >> 4, i = rho & 15; return 8 * (i >> 2) + 4 * n + (i & 3); }

struct Unit { int pm, pn; };
struct Gemm { const bf16_t* A; const bf16_t* Bt; int M, N, K; };

struct StaticOrder {
    int nM, nN, nwg, G, c;
    __host__ __device__ void init(int M, int N, int G_, int c_) { nM = M / BM; nN = N / BM; nwg = nM * nN; G = G_; c = c_; }
    __host__ __device__ bool next(int i, Unit& u) const {
        const long L = (long)i * G + c; if (L >= nwg) return false;
        int wgid = (int)L; { const int q = nwg / NXCD, r = nwg % NXCD, xcd = wgid % NXCD, off = wgid / NXCD; wgid = (xcd < r ? xcd * (q + 1) : r * (q + 1) + (xcd - r) * q) + off; }
        const int nig = WGM * nN, gid = wgid / nig, fm = gid * WGM, gsz = (nM - fm) < WGM ? (nM - fm) : WGM;
        u.pm = fm + ((wgid % nig) % gsz); u.pn = (wgid % nig) / gsz; return true;
    }
    __device__ __forceinline__ void a_ready(const Unit&) const {}
    __device__ __forceinline__ void done(const Unit&) const {}
};

__device__ __forceinline__ unsigned cvt_pk_bf16(float lo, float hi) { unsigned r; asm volatile("v_cvt_pk_bf16_f32 %0, %1, %2" : "=v"(r) : "v"(lo), "v"(hi)); return r; }
struct EpiSplit {
    static constexpr bool PERM = true, AFTER_DRAIN = false;
    bf16_t* O; size_t split_stride; int scale_split; float scale; unsigned rope_mask; const float* cs;
    __device__ __forceinline__ void operator()(const f32x4 (&acc)[2][2][4][2], const Unit& u, int wr, int wc, int fr, int fq) const {
        const int row0 = u.pm * BM + wr * 64 + fr; int colt = u.pn * BM;
        const int t = colt >> 10; bf16_t* base = O + (size_t)t * split_stride; colt &= 1023;
        const float sc = (t == scale_split) ? scale : 1.f;
        const int col0 = colt + wc * 32 + 8 * fq;
        const bool rope = ((rope_mask >> t) & 1u) && !(wc & 1);
#pragma unroll
        for (int ai = 0; ai < 2; ++ai)
#pragma unroll
            for (int m = 0; m < 4; ++m) {
                const int row = row0 + ai * HALF + m * 16;
                bf16_t* rowp = base + (size_t)row * 1024 + col0;
                f32x4 c0 = {1.f, 1.f, 1.f, 1.f}, c1 = c0, s0 = {0.f, 0.f, 0.f, 0.f}, s1 = s0;
                if (rope) { const f32x4* cp = (const f32x4*)(cs + (size_t)row * 16); c0 = cp[0]; c1 = cp[1]; s0 = cp[2]; s1 = cp[3];
                    if (fq == 0) { s0 = -s0; s1 = -s1; } else if (fq >= 2) { c0 = (f32x4){1.f, 1.f, 1.f, 1.f}; c1 = c0; s0 = (f32x4){0.f, 0.f, 0.f, 0.f}; s1 = s0; } }
#pragma unroll
                for (int bj = 0; bj < 2; ++bj) { f32x4 v0 = acc[ai][bj][m][0], v1 = acc[ai][bj][m][1];
                    if (rope) { f32x4 p0, p1;
#pragma unroll
                        for (int e = 0; e < 4; ++e) { p0[e] = __shfl_xor(v0[e], 16); p1[e] = __shfl_xor(v1[e], 16); }
                        v0 = v0 * c0 + p0 * s0; v1 = v1 * c1 + p1 * s1; }
                    v0 = v0 * sc; v1 = v1 * sc; u32x4 w; w.x = cvt_pk_bf16(v0[0], v0[1]); w.y = cvt_pk_bf16(v0[2], v0[3]); w.z = cvt_pk_bf16(v1[0], v1[1]); w.w = cvt_pk_bf16(v1[2], v1[3]);
                    *(u32x4*)(rowp + bj * HALF) = w; } }
    }
};
struct EpiF32 {
    static constexpr bool PERM = false, AFTER_DRAIN = false;
    float* C; int ldc;
    __device__ __forceinline__ void operator()(const f32x4 (&acc)[2][2][4][2], const Unit& u, int wr, int wc, int fr, int fq) const {
        const int row0 = u.pm * BM + wr * 64 + fr, col0 = u.pn * BM + wc * 32 + 4 * fq;
#pragma unroll
        for (int ai = 0; ai < 2; ++ai)
#pragma unroll
            for (int m = 0; m < 4; ++m) { float* rowp = C + (size_t)(row0 + ai * HALF + m * 16) * ldc + col0;
#pragma unroll
                for (int bj = 0; bj < 2; ++bj)
#pragma unroll
                    for (int n = 0; n < 2; ++n) *(f32x4*)(rowp + bj * HALF + n * 16) = acc[ai][bj][m][n]; }
    }
};
template <class Epi, class Sched, bool ALIGN_EPI = false, bool SP2 = false>
__device__ __forceinline__ void gemm_phase(PG8_LAS unsigned char* lds, const Gemm g, const Sched& S, const Epi& E) {
    const int tid = threadIdx.x, wid = __builtin_amdgcn_readfirstlane(tid >> 6), lane = tid & 63, wr = wid >> 2, wc = wid & 3, fr = lane & 15, fq = lane >> 4;
    const int K = g.K, nt = K / BK;
    unsigned voffA[2], voffB[2];
#pragma unroll
    for (int i = 0; i < 2; ++i) { int R, C; stage_rc(tid * 16 + i * 8192, R, C); const int Rb = Epi::PERM ? ((R & ~31) + perm32(R & 31)) : R;
        voffA[i] = (unsigned)(R * K + C) * 2u; voffB[i] = (unsigned)(Rb * K + C) * 2u; }
    const size_t kstep = (size_t)(BK * 2);
    const size_t hstep = (size_t)HALF * K * 2;
    const size_t tstep = 2 * hstep;
    const unsigned ldsw = (unsigned)wid * 1024u;
    const int aoff = lds_byte(wr * 64 + fr, fq * 8), boff = lds_byte(wc * 32 + fr, fq * 8);
#define PG8_SA(b, h) (((b) * 2 + (h)) * HTB)
#define PG8_SB(b, h) ((4 + (b) * 2 + (h)) * HTB)
#define PG8_STAGE(bufoff, gbase, voff) do { _Pragma("unroll") for (int _i = 0; _i < 2; ++_i) \
        __builtin_amdgcn_global_load_lds((const unsigned*)((const char*)(gbase) + (voff)[_i]), (PG8_LAS unsigned*)(lds + (bufoff) + ldsw + _i * 8192), 16, 0, 0); } while (0)
#define PG8_LDA(dst, b, h) do { _Pragma("unroll") for (int m = 0; m < 4; ++m) _Pragma("unroll") for (int k = 0; k < 2; ++k) dst[m][k] = *(const PG8_LAS bf16x8*)(lds + PG8_SA(b, h) + aoff + m * 2048 + k * 1024); } while (0)
#define PG8_LDB(dst, b, h) do { _Pragma("unroll") for (int n = 0; n < 2; ++n) _Pragma("unroll") for (int k = 0; k < 2; ++k) dst[n][k] = *(const PG8_LAS bf16x8*)(lds + PG8_SB(b, h) + boff + n * 2048 + k * 1024); } while (0)
#define PG8_MMA(ai, bj, At, Bt) do { __builtin_amdgcn_s_setprio(1); _Pragma("unroll") for (int m = 0; m < 4; ++m) _Pragma("unroll") for (int n = 0; n < 2; ++n) _Pragma("unroll") for (int k = 0; k < 2; ++k) \
        acc[ai][bj][m][n] = __builtin_amdgcn_mfma_f32_16x16x32_bf16(Bt[n][k], At[m][k], acc[ai][bj][m][n], 0, 0, 0); __builtin_amdgcn_s_setprio(0); } while (0)
#define PG8_WAIT_V(n) asm volatile("s_waitcnt vmcnt(" #n ")" ::: "memory")
#define PG8_WAIT_L(n) asm volatile("s_waitcnt lgkmcnt(" #n ")" ::: "memory")
#define PG8_BAR __builtin_amdgcn_s_barrier()
#define PG8_SCHED __builtin_amdgcn_sched_barrier(0)
    Unit cur, nxt; int ui = 0;
    if (!S.next(0, cur)) return;
    f32x4 acc[2][2][4][2];
#pragma unroll
    for (int a = 0; a < 2; ++a)
#pragma unroll
        for (int b = 0; b < 2; ++b)
#pragma unroll
            for (int m = 0; m < 4; ++m)
#pragma unroll
                for (int n = 0; n < 2; ++n) acc[a][b][m][n] = (f32x4){0.f, 0.f, 0.f, 0.f};
    bf16x8 At[4][2], B0[2][2], B1[2][2];
    const char* cA = (const char*)g.A + (size_t)cur.pm * tstep; const char* cB = (const char*)g.Bt + (size_t)cur.pn * tstep;
    S.a_ready(cur);
    if constexpr (SP2) {
        PG8_STAGE(PG8_SB(0, 0), cB, voffB); PG8_STAGE(PG8_SB(0, 1), cB + hstep, voffB); PG8_STAGE(PG8_SA(0, 0), cA, voffA); PG8_STAGE(PG8_SA(0, 1), cA + hstep, voffA);
        if (wr == 1) PG8_BAR;
        PG8_WAIT_V(2); PG8_BAR;
        PG8_STAGE(PG8_SB(1, 0), cB + kstep, voffB); PG8_STAGE(PG8_SA(1, 0), cA + kstep, voffA); PG8_STAGE(PG8_SB(1, 1), cB + hstep + kstep, voffB);
        PG8_WAIT_V(6); PG8_BAR;
    } else {
        PG8_STAGE(PG8_SB(0, 0), cB, voffB); PG8_STAGE(PG8_SA(0, 0), cA, voffA); PG8_STAGE(PG8_SB(0, 1), cB + hstep, voffB); PG8_STAGE(PG8_SA(0, 1), cA + hstep, voffA);
        if (wr == 1) PG8_BAR;
        PG8_WAIT_V(4); PG8_BAR;
        PG8_STAGE(PG8_SB(1, 0), cB + kstep, voffB); PG8_STAGE(PG8_SA(1, 0), cA + kstep, voffA); PG8_STAGE(PG8_SB(1, 1), cB + hstep + kstep, voffB);
        PG8_WAIT_V(6); PG8_BAR;
    }
    for (;;) {
        const bool has_next = S.next(ui + 1, nxt);
        const char* nA = has_next ? (const char*)g.A + (size_t)nxt.pm * tstep : cA; const char* nB = has_next ? (const char*)g.Bt + (size_t)nxt.pn * tstep : cB;
        for (int t = 0; t < nt; t += 2) {
            const bool last = (t == nt - 2);
            const char* a1 = cA + (size_t)(t + 1) * kstep;
            const char* a2 = last ? nA : cA + (size_t)(t + 2) * kstep; const char* b2 = last ? nB : cB + (size_t)(t + 2) * kstep;
            const char* a3 = a2 + kstep; const char* b3 = b2 + kstep;
            if (last && has_next) S.a_ready(nxt);
            if constexpr (SP2) {
            PG8_LDB(B0, 0, 0); PG8_LDB(B1, 0, 1); PG8_SCHED; PG8_LDA(At, 0, 0); PG8_STAGE(PG8_SA(1, 1), a1 + hstep, voffA);
            PG8_WAIT_V(8); PG8_WAIT_L(0); PG8_BAR; PG8_MMA(0, 0, At, B0); PG8_MMA(0, 1, At, B1); PG8_BAR; PG8_SCHED;
            PG8_LDA(At, 0, 1); PG8_STAGE(PG8_SB(0, 0), b2, voffB); PG8_STAGE(PG8_SB(0, 1), b2 + hstep, voffB); PG8_STAGE(PG8_SA(0, 0), a2, voffA);
            PG8_WAIT_V(8); PG8_WAIT_L(0); PG8_BAR; PG8_MMA(1, 0, At, B0); PG8_MMA(1, 1, At, B1); PG8_BAR; PG8_SCHED;
            PG8_LDB(B0, 1, 0); PG8_LDB(B1, 1, 1); PG8_SCHED; PG8_LDA(At, 1, 0); PG8_STAGE(PG8_SA(0, 1), a2 + hstep, voffA);
            PG8_WAIT_V(8); PG8_WAIT_L(0); PG8_BAR; PG8_MMA(0, 0, At, B0); PG8_MMA(0, 1, At, B1); PG8_BAR; PG8_SCHED;
            PG8_LDA(At, 1, 1); PG8_STAGE(PG8_SB(1, 0), b3, voffB); PG8_STAGE(PG8_SB(1, 1), b3 + hstep, voffB); PG8_STAGE(PG8_SA(1, 0), a3, voffA);
            PG8_WAIT_V(8); PG8_WAIT_L(0); PG8_BAR; PG8_MMA(1, 0, At, B0); PG8_MMA(1, 1, At, B1); PG8_BAR; PG8_SCHED;
            } else {
            PG8_LDB(B0, 0, 0); PG8_SCHED; PG8_LDA(At, 0, 0); PG8_STAGE(PG8_SA(1, 1), a1 + hstep, voffA);
            PG8_WAIT_L(8); PG8_BAR; PG8_WAIT_L(0); PG8_MMA(0, 0, At, B0); PG8_BAR; PG8_SCHED;
            PG8_LDB(B1, 0, 1); PG8_STAGE(PG8_SB(0, 0), b2, voffB);
            PG8_BAR; PG8_WAIT_L(0); PG8_MMA(0, 1, At, B1); PG8_BAR;
            PG8_LDA(At, 0, 1); PG8_STAGE(PG8_SA(0, 0), a2, voffA);
            PG8_BAR; PG8_WAIT_L(0); PG8_MMA(1, 0, At, B0); PG8_BAR; PG8_SCHED;
            PG8_STAGE(PG8_SB(0, 1), b2 + hstep, voffB);
            PG8_WAIT_V(6); PG8_BAR; PG8_MMA(1, 1, At, B1); PG8_BAR;
            PG8_LDB(B0, 1, 0); PG8_SCHED; PG8_LDA(At, 1, 0); PG8_STAGE(PG8_SA(0, 1), a2 + hstep, voffA);
            PG8_WAIT_L(8); PG8_BAR; PG8_WAIT_L(0); PG8_MMA(0, 0, At, B0); PG8_BAR; PG8_SCHED;
            PG8_LDB(B1, 1, 1); PG8_STAGE(PG8_SB(1, 0), b3, voffB);
            PG8_BAR; PG8_WAIT_L(0); PG8_MMA(0, 1, At, B1); PG8_BAR;
            PG8_LDA(At, 1, 1); PG8_STAGE(PG8_SA(1, 0), a3, voffA);
            PG8_BAR; PG8_WAIT_L(0); PG8_MMA(1, 0, At, B0); PG8_BAR; PG8_SCHED;
            PG8_STAGE(PG8_SB(1, 1), b3 + hstep, voffB);
            PG8_WAIT_V(6); PG8_BAR; PG8_MMA(1, 1, At, B1); PG8_BAR;
            }
        }
        if constexpr (ALIGN_EPI) { if (wr == 0) PG8_BAR; }
        if constexpr (!Epi::AFTER_DRAIN) { E(acc, cur, wr, wc, fr, fq); S.done(cur); }
        if (!has_next) break;
#pragma unroll
        for (int a = 0; a < 2; ++a)
#pragma unroll
            for (int b = 0; b < 2; ++b)
#pragma unroll
                for (int m = 0; m < 4; ++m)
#pragma unroll
                    for (int n = 0; n < 2; ++n) acc[a][b][m][n] = (f32x4){0.f, 0.f, 0.f, 0.f};
        cur = nxt; cA = nA; cB = nB; ++ui;
        if constexpr (ALIGN_EPI) { if (wr == 1) PG8_BAR; }
    }
    PG8_WAIT_V(0);
    if constexpr (!ALIGN_EPI) { if (wr == 0) PG8_BAR; }
    PG8_BAR;
    if constexpr (Epi::AFTER_DRAIN) { E.fused(acc, cur, wr, wc, fr, fq, lds, wid, lane); S.done(cur); }
#undef PG8_SA
#undef PG8_SB
#undef PG8_STAGE
#undef PG8_LDA
#undef PG8_LDB
#undef PG8_MMA
#undef PG8_WAIT_V
#undef PG8_WAIT_L
#undef PG8_BAR
#undef PG8_SCHED
}
}
namespace att {
#define ATT_LAS __attribute__((address_space(3)))
typedef ATT_LAS unsigned char lds_u8;
typedef const ATT_LAS unsigned char* lds_cptr;
using bf16x8 = __attribute__((ext_vector_type(8))) short;
using s16x4 = __attribute__((ext_vector_type(4))) short;
using f32x16 = __attribute__((ext_vector_type(16))) float;
using u32x4 = __attribute__((ext_vector_type(4))) unsigned;
using f32x4 = __attribute__((ext_vector_type(4))) float;
typedef float f32x2_t __attribute__((ext_vector_type(2))); typedef __bf16 bf16x2_t __attribute__((ext_vector_type(2)));
typedef short v4i16_t __attribute__((ext_vector_type(4)));
__device__ __forceinline__ int crow(int r, int hi) { return (r & 3) + 8 * (r >> 2) + 4 * hi; }
#define ATT_SB() __builtin_amdgcn_sched_barrier(0)
#define ATT_PIN(x) asm volatile("" : "+v"(x))
#define ATT_WAIT_BAR(N) asm volatile("s_waitcnt vmcnt(" #N ") lgkmcnt(0)\n\ts_barrier" ::: "memory")
constexpr float THRL = 8.0f;
__device__ __forceinline__ void glds16(const void* gsrc, unsigned lds_dst) { unsigned keep;
    asm volatile("s_mov_b32 %0, m0\n\ts_mov_b32 m0, %2\n\ts_nop 0\n\tglobal_load_lds_dwordx4 %1, off\n\ts_mov_b32 m0, %0" : "=&s"(keep) : "v"(gsrc), "s"(lds_dst) : "memory"); }
__device__ __forceinline__ unsigned cvtpk(float lo, float hi) { f32x2_t v = {lo, hi}; bf16x2_t b = __builtin_convertvector(v, bf16x2_t); return __builtin_bit_cast(unsigned, b); }
__device__ __forceinline__ float silu(float g) { return g * __builtin_amdgcn_rcpf(1.f + __builtin_amdgcn_exp2f(-g * LOG2E)); }
__device__ __forceinline__ s16x4 vtr(lds_cptr p) { return __builtin_bit_cast(s16x4, __builtin_amdgcn_ds_read_tr16_b64_v4i16((ATT_LAS v4i16_t*)p)); }
#define ATT_MX3(a, b, c) __builtin_fmaxf(__builtin_fmaxf((a), (b)), (c))

#ifndef PROBE
#define PROBE 0
#endif
struct Prof { unsigned long long wait, step, pro, epi; };
#if PROBE
#define PRT() __builtin_amdgcn_s_memrealtime()
#else
#define PRT() 0ull
#endif
struct NoBias { __device__ __forceinline__ void operator()(f32x16&, f32x16&) const {} };

template <int NDV, bool DO_QK, bool DO_PV, bool QLDS, class Bias>
__device__ __forceinline__ void att_step(lds_cptr kslot, const int* koff, const bf16x8* qreg, lds_cptr qpark, lds_cptr vslot, const int* voff,
                                         u32x4& pw0, u32x4& pw1, u32x4& pw2, u32x4& pw3, float& mhat, float& l, f32x16& negm, f32x16* o,
                                         ATT_LAS float* wsf, int r32, int hi, bool first, const Bias& bias) {
    constexpr int RS = NDV * 64, NM = NDV * 4, EPG = 32 / NM, VPRE = (NDV == 2) ? 8 : 4;
    constexpr int PLAG = (NDV == 2) ? 2 : 4;
    bf16x8 kf[8]; bf16x8 vf[NM]; f32x16 C0, C1; bf16x8 qr[4];
    if (DO_QK) {
#pragma unroll
        for (int d0 = 0; d0 < 4; ++d0) qr[d0] = QLDS ? *(const ATT_LAS bf16x8*)(qpark + d0 * 1024) : qreg[d0]; }
#define ATT_KRD(i) do { if (DO_QK) kf[i] = *(const ATT_LAS bf16x8*)(kslot + koff[(i) >> 1] + ((i) & 1) * 4096); } while (0)
    ATT_KRD(0); ATT_KRD(1); ATT_KRD(2); ATT_KRD(3);
#define ATT_VRD(j) do { if (DO_PV) { const int ks_ = (j) / NDV, d0_ = (j) % NDV; const s16x4 lo_ = vtr(vslot + voff[d0_] + ks_ * 16 * RS), hi_ = vtr(vslot + voff[d0_] + ks_ * 16 * RS + 8 * RS); \
        vf[j] = (bf16x8){lo_[0], lo_[1], lo_[2], lo_[3], hi_[0], hi_[1], hi_[2], hi_[3]}; } } while (0)
#pragma unroll
    for (int i = 0; i < 8; ++i) {
        if (i >= 8 - VPRE) { ATT_VRD(i - (8 - VPRE)); ATT_SB(); }
        if (DO_QK) { if (i & 1) C1 = __builtin_amdgcn_mfma_f32_32x32x16_bf16(kf[i], qr[i >> 1], i < 2 ? negm : C1, 0, 0, 0);
                     else       C0 = __builtin_amdgcn_mfma_f32_32x32x16_bf16(kf[i], qr[i >> 1], i < 2 ? negm : C0, 0, 0, 0); }
        if (i < 4) ATT_KRD(i + 4);
        ATT_SB();
    }
    bool resc = false;
    if (DO_QK) {
        bias(C0, C1);
        float a = ATT_MX3(C0[0], C0[1], C1[0]), b = ATT_MX3(C0[2], C0[3], C1[1]); a = ATT_MX3(a, C1[2], C1[3]);
#pragma unroll
        for (int r = 4; r < 16; r += 4) { a = ATT_MX3(a, C0[r], C0[r + 1]); b = ATT_MX3(b, C0[r + 2], C0[r + 3]); a = ATT_MX3(a, C1[r], C1[r + 1]); b = ATT_MX3(b, C1[r + 2], C1[r + 3]); }
        float rm = __builtin_fmaxf(a, b);
        { auto rr = __builtin_amdgcn_permlane32_swap(__float_as_uint(rm), __float_as_uint(rm), false, false); rm = __builtin_fmaxf(__uint_as_float(rr[0]), __uint_as_float(rr[1])); }
        if (first) {
            mhat = rm;
#pragma unroll
            for (int r = 0; r < 16; ++r) { C0[r] -= rm; C1[r] -= rm; }
#pragma unroll
            for (int r = 0; r < 16; ++r) negm[r] = -mhat;
            ATT_PIN(negm);
        } else if (__builtin_expect(__any(rm > THRL), 0)) {
            const float dl = __builtin_fmaxf(rm, 0.f); mhat += dl;
#pragma unroll
            for (int r = 0; r < 16; ++r) { C0[r] -= dl; C1[r] -= dl; }
#pragma unroll
            for (int r = 0; r < 16; ++r) negm[r] = -mhat;
            ATT_PIN(negm);
            const float f = __builtin_amdgcn_exp2f(-dl); l *= f; if (hi == 0) wsf[r32] = f; resc = true;
        }
    }
    ATT_SB();
#define ATT_EL(e) (((e) < 16) ? C0[(e) & 15] : C1[(e) & 15])
#define ATT_EXP(e) do { if ((e) < 16) C0[(e) & 15] = __builtin_amdgcn_exp2f(C0[(e) & 15]); else C1[(e) & 15] = __builtin_amdgcn_exp2f(C1[(e) & 15]); } while (0)
#define ATT_PKW(w) do { const unsigned v_ = cvtpk(ATT_EL(2 * (w)), ATT_EL(2 * (w) + 1)); if (((w) >> 2) == 0) pw0[(w) & 3] = v_; else if (((w) >> 2) == 1) pw1[(w) & 3] = v_; else if (((w) >> 2) == 2) pw2[(w) & 3] = v_; else pw3[(w) & 3] = v_; } while (0)
    float sacc = 0.f;
#pragma unroll
    for (int j = 0; j < NM; ++j) {
        if (NDV == 4 && j + VPRE < NM) { ATT_VRD((j + VPRE) % NM); }
        if (DO_PV) { const int ks = j / NDV, d0 = j % NDV;
            const bf16x8 pa = ks == 0 ? __builtin_bit_cast(bf16x8, pw0) : ks == 1 ? __builtin_bit_cast(bf16x8, pw1) : ks == 2 ? __builtin_bit_cast(bf16x8, pw2) : __builtin_bit_cast(bf16x8, pw3);
            o[d0] = __builtin_amdgcn_mfma_f32_32x32x16_bf16(pa, vf[j], o[d0], 0, 0, 0); }
        if (DO_QK) {
#pragma unroll
            for (int x = 0; x < EPG; ++x) ATT_EXP(j * EPG + x);
            if (j > 0) {
#pragma unroll
                for (int x = 0; x < EPG; ++x) sacc += ATT_EL((j - 1) * EPG + x);
            }
            if (j >= PLAG) {
#pragma unroll
                for (int x = 0; x < EPG / 2; ++x) ATT_PKW(((j - PLAG) * EPG) / 2 + x);
            }
            ATT_PIN(sacc); }
        ATT_SB();
    }
    if (DO_QK) {
#pragma unroll
        for (int x = 0; x < EPG; ++x) sacc += ATT_EL((NM - 1) * EPG + x);
#pragma unroll
        for (int g = NM - PLAG; g < NM; ++g)
#pragma unroll
            for (int x = 0; x < EPG / 2; ++x) ATT_PKW((g * EPG) / 2 + x);
        l += sacc;
    }
    if (DO_QK && resc) {
        asm volatile("s_waitcnt lgkmcnt(0)" ::: "memory");
        float al[16];
#pragma unroll
        for (int r = 0; r < 16; ++r) al[r] = wsf[crow(r, hi)];
#pragma unroll
        for (int d = 0; d < NDV; ++d)
#pragma unroll
            for (int r = 0; r < 16; ++r) o[d][r] *= al[r];
    }
#undef ATT_VRD
#undef ATT_KRD
#undef ATT_EL
#undef ATT_EXP
#undef ATT_PKW
}
#define ATT_STEP(NDV, QL, qk, pv, KS, VS, first, BIAS) do { \
    if ((qk) && (pv)) att_step<NDV, true, true, QL>(KS, koff, qr, qpark, VS, voff, pw0, pw1, pw2, pw3, mhat, l, negm, o, wsf, r32, hi, first, BIAS); \
    else if (qk) att_step<NDV, true, false, QL>(KS, koff, qr, qpark, VS, voff, pw0, pw1, pw2, pw3, mhat, l, negm, o, wsf, r32, hi, first, BIAS); \
    else if (pv) att_step<NDV, false, true, QL>(KS, koff, qr, qpark, VS, voff, pw0, pw1, pw2, pw3, mhat, l, negm, o, wsf, r32, hi, first, BIAS); } while (0)

constexpr int A_KR = 0, A_VR = 3 * 8192, A_WS = A_VR + 4 * 8192, A_OST = A_WS + 2048, A_BIAS = A_OST + 32768, A_POSK = A_BIAS + 1280, A_TMAX = A_POSK + 3072, A_TMIN = A_TMAX + 64, A_BYTES = A_TMIN + 64;
struct BiasA {
    ATT_LAS const float* bias2; ATT_LAS const int* posk; int kmx, kmn, qpos, hi;
    __device__ __forceinline__ void operator()(f32x16& p0, f32x16& p1) const {
        if (__all(qpos - kmx >= MAXREL)) { const float bb = bias2[2 * MAXREL];
#pragma unroll
            for (int r = 0; r < 16; ++r) { p0[r] += bb; p1[r] += bb; } }
        else if (__all(qpos - kmn <= -MAXREL)) { const float bb = bias2[0];
#pragma unroll
            for (int r = 0; r < 16; ++r) { p0[r] += bb; p1[r] += bb; } }
        else {
#pragma unroll
            for (int r4 = 0; r4 < 16; r4 += 4) {
#pragma unroll
                for (int r = r4; r < r4 + 4; ++r) { const int kk = crow(r, hi);
                    int r0 = qpos - posk[kk], r1 = qpos - posk[kk + 32];
                    r0 = min(max(r0, -MAXREL), MAXREL) + MAXREL; r1 = min(max(r1, -MAXREL), MAXREL) + MAXREL;
                    p0[r] += bias2[r0]; p1[r] += bias2[r1]; }
                ATT_SB(); } }
    }
};
__device__ __forceinline__ void attn_a_unit(int b, int h, int u, const bf16_t* Q, const bf16_t* K, const bf16_t* V, const bf16_t* G, bf16_t* O, const int* pos, const float* relb, lds_u8* shm, Prof& prof) {
    const unsigned long long pt0 = PRT();
    int tid = threadIdx.x; asm volatile("" : "+v"(tid));
    const int lane = tid & 63, r32 = lane & 31, hi = lane >> 5; const int wid = __builtin_amdgcn_readfirstlane(tid >> 6);
    const long rowbase = (long)b * SEQ; const int q0 = u * 256;
    const int c0 = 4 * u, kc_lo = (c0 - PAST) > 0 ? (c0 - PAST) : 0, NT = c0 + 3 - kc_lo + 1;
    const int cw = c0 + (wid >> 1); const int t_lo = ((cw - PAST) > 0 ? (cw - PAST) : 0) - kc_lo, t_hi = cw - kc_lo;
    ATT_LAS float* wsf = (ATT_LAS float*)(shm + A_WS) + wid * 64;
    ATT_LAS float* bias2 = (ATT_LAS float*)(shm + A_BIAS);
    ATT_LAS int* posk = (ATT_LAS int*)(shm + A_POSK);
    ATT_LAS int* tmax = (ATT_LAS int*)(shm + A_TMAX); ATT_LAS int* tmin = (ATT_LAS int*)(shm + A_TMIN);
    const unsigned lds0 = (unsigned)(uintptr_t)shm;
    const bf16_t* Kh = K + (rowbase + (long)kc_lo * 64) * DM + h * 64; const bf16_t* Vh = V + (rowbase + (long)kc_lo * 64) * DM + h * 64;
    const int drow = 8 * wid + (lane >> 3), dpos = lane & 7;
    const bf16_t* ksrc = Kh + (long)drow * DM + ((dpos ^ ((drow >> 1) & 7)) * 8);
    const bf16_t* vsrc = Vh + (long)drow * DM + ((dpos ^ (((drow >> 1) & 1) << 2)) * 8);
    const unsigned kdst = lds0 + A_KR + wid * 1024, vdst = lds0 + A_VR + wid * 1024;
#define A_DMA(t, kso, vso) do { glds16(ksrc + (long)(t) * 64 * DM, (unsigned)__builtin_amdgcn_readfirstlane(kdst + (kso))); glds16(vsrc + (long)(t) * 64 * DM, (unsigned)__builtin_amdgcn_readfirstlane(vdst + (vso))); } while (0)
    A_DMA(0, 0, 0); if (NT > 1) A_DMA(1, 8192, 8192);
    int koff[4];
#pragma unroll
    for (int d0 = 0; d0 < 4; ++d0) koff[d0] = r32 * 128 + (((2 * d0 + hi) ^ ((r32 >> 1) & 7)) << 4);
    int voff[2]; { const int q_ = (lane & 15) >> 2, xq = (q_ >> 1) & 1; const int base = (4 * hi + q_) * 128 + ((lane >> 4) & 1) * 32 + (lane & 3) * 8; voff[0] = base + xq * 64; voff[1] = base + (xq ^ 1) * 64; }
    if (tid < NREL) bias2[tid] = relb[h * NREL + tid] * LOG2E;
    for (int i = tid; i < NT * 64; i += 512) posk[i] = pos[rowbase + kc_lo * 64 + i];
    asm volatile("s_waitcnt lgkmcnt(0)\n\ts_barrier" ::: "memory");
    for (int t = wid; t < NT; t += 8) { int v = posk[t * 64 + lane]; int mx = v, mn = v;
#pragma unroll
        for (int o_ = 1; o_ < 64; o_ <<= 1) { mx = max(mx, __shfl_xor(mx, o_)); mn = min(mn, __shfl_xor(mn, o_)); }
        if (lane == 0) { tmax[t] = mx; tmin[t] = mn; } }
    const bf16_t* Qw = Q + (rowbase + q0 + wid * 32) * DM + h * 64;
    bf16x8 qr[4];
#pragma unroll
    for (int d0 = 0; d0 < 4; ++d0) qr[d0] = *reinterpret_cast<const bf16x8*>(&Qw[(long)r32 * DM + d0 * 16 + hi * 8]);
    int qpos = pos[rowbase + q0 + wid * 32 + r32];
    const lds_cptr qpark = (lds_cptr)shm;
    asm volatile("" : "+v"(qr[0]), "+v"(qr[1]), "+v"(qr[2]), "+v"(qr[3]), "+v"(qpos));
    float zero_ = 0.f; asm volatile("" : "+v"(zero_));
    float mhat = 0.f, l = 0.f; f32x16 o[2], negm;
#pragma unroll
    for (int r = 0; r < 16; ++r) { o[0][r] = zero_; o[1][r] = zero_; negm[r] = zero_; }
    u32x4 pw0 = {0u, 0u, 0u, 0u}, pw1 = pw0, pw2 = pw0, pw3 = pw0;
    int k_cur = 0, k_p2 = 2 * 8192;
#define A_ROT() do { k_cur = (k_cur == 2 * 8192) ? 0 : k_cur + 8192; k_p2 = (k_p2 == 2 * 8192) ? 0 : k_p2 + 8192; } while (0)
#define A_ONE(t) do { const unsigned long long pa_ = PRT(); \
        if ((t) + 1 < NT) ATT_WAIT_BAR(2); else ATT_WAIT_BAR(0);        \
        const unsigned long long pb_ = PRT(); prof.wait += pb_ - pa_; \
        if ((t) + 2 < NT) A_DMA((t) + 2, k_p2, (((t) + 2) & 3) * 8192); \
        const bool qk_ = (t) >= t_lo && (t) <= t_hi, pv_ = (t) - 1 >= t_lo && (t) - 1 <= t_hi; \
        BiasA bias_{bias2, posk + ((t) < NT ? (t) : 0) * 64, 0, 0, qpos, hi}; if (qk_) { bias_.kmx = tmax[t]; bias_.kmn = tmin[t]; } \
        ATT_STEP(2, false, qk_, pv_, (lds_cptr)(shm + A_KR + k_cur), (lds_cptr)(shm + A_VR + (((t) - 1) & 3) * 8192), (t) == t_lo, bias_); \
        prof.step += PRT() - pb_; \
        A_ROT(); } while (0)
    const unsigned long long pt1 = PRT(); prof.pro += pt1 - pt0;
    for (int t = 0; t <= NT; ++t) A_ONE(t);
    const unsigned long long pt2 = PRT();
#undef A_ONE
#undef A_ROT
#undef A_DMA
    { auto rr = __builtin_amdgcn_permlane32_swap(__float_as_uint(l), __float_as_uint(l), false, false); l = __uint_as_float(rr[0]) + __uint_as_float(rr[1]); }
    if (hi == 0) wsf[32 + r32] = l; asm volatile("s_waitcnt lgkmcnt(0)" ::: "memory");
    float rli[16];
#pragma unroll
    for (int r = 0; r < 16; ++r) rli[r] = __builtin_amdgcn_rcpf(wsf[32 + crow(r, hi)]);
    { ATT_LAS bf16_t* stg = (ATT_LAS bf16_t*)(shm + A_OST) + wid * 2048;
#pragma unroll
        for (int r = 0; r < 16; ++r) { const int orow = crow(r, hi);
#pragma unroll
            for (int d0 = 0; d0 < 2; ++d0) stg[orow * 64 + d0 * 32 + r32] = f2bf(o[d0][r] * rli[r]); }
        asm volatile("s_waitcnt lgkmcnt(0)" ::: "memory");
        const long orow0 = rowbase + q0 + wid * 32;
        int lane_e = lane; asm volatile("" : "+v"(lane_e));
#pragma unroll
        for (int i = 0; i < 4; ++i) { const int row = i * 8 + (lane_e >> 3), ch = lane_e & 7;
            const u32x4 v = *(const ATT_LAS u32x4*)(stg + row * 64 + ch * 8);
            const u32x4 g = *(const u32x4*)(G + (orow0 + row) * DM + h * 64 + ch * 8);
            u32x4 w;
#pragma unroll
            for (int e = 0; e < 4; ++e) { const float v0 = __uint_as_float(v[e] << 16), v1 = __uint_as_float(v[e] & 0xffff0000u), g0 = __uint_as_float(g[e] << 16), g1 = __uint_as_float(g[e] & 0xffff0000u);
                w[e] = cvtpk(v0 * silu(g0), v1 * silu(g1)); }
            *(u32x4*)(O + (orow0 + row) * DM + h * 64 + ch * 8) = w; } }
    asm volatile("s_waitcnt vmcnt(0) lgkmcnt(0)\n\ts_barrier" ::: "memory");
    prof.epi += PRT() - pt2;
}

constexpr int B_KR = 0, B_VR = 3 * 16384, B_WS = B_VR + 4 * 16384, B_X = 0, B_OST = 65536, B_QP = B_WS + 2048, B_BYTES = B_QP + 32768;
__device__ __forceinline__ void attn_b_unit(int b, int h, int qb, const bf16_t* Q, const bf16_t* K, const bf16_t* V, const bf16_t* G, bf16_t* O, const float* subln, float lam, lds_u8* shm, Prof& prof) {
    const unsigned long long pt0 = PRT();
    int tid = threadIdx.x; asm volatile("" : "+v"(tid));
    const int lane = tid & 63, r32 = lane & 31, hi = lane >> 5; const int wid = __builtin_amdgcn_readfirstlane(tid >> 6);
    const int map = wid >> 2, wq = wid & 3;
    const long rowbase = (long)b * SEQ; const int q0 = qb * 128;
    const int NT = 2 * qb + 2; const int t_lo = 0, t_hi = 2 * qb + (wq >> 1);
    ATT_LAS float* wsf = (ATT_LAS float*)(shm + B_WS) + wid * 64;
    const unsigned lds0 = (unsigned)(uintptr_t)shm;
    const bf16_t* Kh = K + rowbase * DM + h * 128; const bf16_t* Vh = V + rowbase * DM + h * 128;
    const int drow = 8 * wid + (lane >> 3), dpos = lane & 7;
    const bf16_t* k0src = Kh + (long)drow * DM + ((dpos ^ ((drow >> 1) & 7)) * 8);
    const bf16_t* k1src = k0src + 64;
    const int vrow = 4 * wid + (lane >> 4), vpos = lane & 15;
    const bf16_t* v0src = Vh + (long)vrow * DM + ((vpos ^ ((vrow & 3) << 2)) * 8);
    const bf16_t* v1src = v0src + (long)32 * DM;
    const unsigned k0dst = lds0 + B_KR + wid * 1024, k1dst = k0dst + 8192, v0dst = lds0 + B_VR + wid * 1024, v1dst = v0dst + 8192;
#define B_DMA(t, kso, vso) do { const long go_ = (long)(t) * 64 * DM; \
        glds16(k0src + go_, (unsigned)__builtin_amdgcn_readfirstlane(k0dst + (kso))); glds16(k1src + go_, (unsigned)__builtin_amdgcn_readfirstlane(k1dst + (kso))); \
        glds16(v0src + go_, (unsigned)__builtin_amdgcn_readfirstlane(v0dst + (vso))); glds16(v1src + go_, (unsigned)__builtin_amdgcn_readfirstlane(v1dst + (vso))); } while (0)
    B_DMA(0, 0, 0); B_DMA(1, 16384, 16384);
    int koff[4];
#pragma unroll
    for (int d0 = 0; d0 < 4; ++d0) koff[d0] = r32 * 128 + (((2 * d0 + hi) ^ ((r32 >> 1) & 7)) << 4);
    int voff[4]; { const int q_ = (lane & 15) >> 2; const int base = (4 * hi + q_) * 256 + ((lane >> 4) & 1) * 32 + (lane & 3) * 8;
#pragma unroll
        for (int d0 = 0; d0 < 4; ++d0) voff[d0] = base + ((d0 ^ q_) * 64); }
    const bf16_t* Qw = Q + (rowbase + q0 + wq * 32) * DM + h * 128 + map * 64;
    const lds_cptr qpark = (lds_cptr)(shm + B_QP + wid * 4096 + lane * 16);
    const bf16x8* qr = nullptr;
    {
        bf16x8 qtmp[4];
#pragma unroll
        for (int d0 = 0; d0 < 4; ++d0) qtmp[d0] = *reinterpret_cast<const bf16x8*>(&Qw[(long)r32 * DM + d0 * 16 + hi * 8]);
#pragma unroll
        for (int d0 = 0; d0 < 4; ++d0) *(ATT_LAS bf16x8*)(shm + B_QP + wid * 4096 + lane * 16 + d0 * 1024) = qtmp[d0];
        asm volatile("s_waitcnt vmcnt(0) lgkmcnt(0)" ::: "memory");
    }
    float zero_ = 0.f; asm volatile("" : "+v"(zero_));
    float mhat = 0.f, l = 0.f; f32x16 o[4], negm;
#pragma unroll
    for (int r = 0; r < 16; ++r) { o[0][r] = zero_; o[1][r] = zero_; o[2][r] = zero_; o[3][r] = zero_; negm[r] = zero_; }
    u32x4 pw0 = {0u, 0u, 0u, 0u}, pw1 = pw0, pw2 = pw0, pw3 = pw0;
    int k_cur = 0, k_p2 = 2 * 16384;
    const NoBias nob{};
#define B_ROT() do { k_cur = (k_cur == 2 * 16384) ? 0 : k_cur + 16384; k_p2 = (k_p2 == 2 * 16384) ? 0 : k_p2 + 16384; } while (0)
#define B_ONE(t) do { const unsigned long long pa_ = PRT(); \
        if ((t) + 1 < NT) ATT_WAIT_BAR(4); else ATT_WAIT_BAR(0); \
        const unsigned long long pb_ = PRT(); prof.wait += pb_ - pa_; \
        if ((t) + 2 < NT) B_DMA((t) + 2, k_p2, (((t) + 2) & 3) * 16384); \
        const bool qk_ = (t) >= t_lo && (t) <= t_hi, pv_ = (t) - 1 >= t_lo && (t) - 1 <= t_hi; \
        ATT_STEP(4, true, qk_, pv_, (lds_cptr)(shm + B_KR + k_cur + map * 8192), (lds_cptr)(shm + B_VR + (((t) - 1) & 3) * 16384), (t) == t_lo, nob); \
        prof.step += PRT() - pb_; \
        B_ROT(); } while (0)
    const unsigned long long pt1 = PRT(); prof.pro += pt1 - pt0;
    for (int t = 0; t <= NT; ++t) B_ONE(t);
    const unsigned long long pt2 = PRT();
#undef B_ONE
#undef B_ROT
#undef B_DMA
    { auto rr = __builtin_amdgcn_permlane32_swap(__float_as_uint(l), __float_as_uint(l), false, false); l = __uint_as_float(rr[0]) + __uint_as_float(rr[1]); }
    if (hi == 0) wsf[32 + r32] = l; asm volatile("s_waitcnt lgkmcnt(0)" ::: "memory");
    float rli[16];
#pragma unroll
    for (int r = 0; r < 16; ++r) rli[r] = __builtin_amdgcn_rcpf(wsf[32 + crow(r, hi)]);
    asm volatile("s_waitcnt lgkmcnt(0)\n\ts_barrier" ::: "memory");
    ATT_LAS float* X = (ATT_LAS float*)(shm + B_X) + wq * 4096;
    if (map == 1) {
#pragma unroll
        for (int d = 0; d < 4; ++d)
#pragma unroll
            for (int r = 0; r < 16; ++r) X[(d * 16 + r) * 64 + lane] = o[d][r] * rli[r] * lam;
    }
    asm volatile("s_waitcnt lgkmcnt(0)\n\ts_barrier" ::: "memory");
    if (map == 0) {
        float ss[16];
#pragma unroll
        for (int r = 0; r < 16; ++r) ss[r] = 0.f;
#pragma unroll
        for (int d = 0; d < 4; ++d)
#pragma unroll
            for (int r = 0; r < 16; ++r) { const float v = o[d][r] * rli[r] - X[(d * 16 + r) * 64 + lane]; o[d][r] = v; ss[r] += v * v; }
#pragma unroll
        for (int r = 0; r < 16; ++r) {
#pragma unroll
            for (int o_ = 1; o_ < 32; o_ <<= 1) ss[r] += __shfl_xor(ss[r], o_);
            ss[r] = rsqrtf(ss[r] * (1.f / 128.f) + EPS) * (1.f - LAM_INIT); }
        ATT_LAS bf16_t* stg = (ATT_LAS bf16_t*)(shm + B_OST) + wq * 4096;
#pragma unroll
        for (int r = 0; r < 16; ++r) { const int orow = crow(r, hi);
#pragma unroll
            for (int d = 0; d < 4; ++d) stg[orow * 128 + d * 32 + r32] = f2bf(o[d][r] * ss[r]); }
        asm volatile("s_waitcnt lgkmcnt(0)" ::: "memory");
        const long orow0 = rowbase + q0 + wq * 32;
        int lane_e = lane; asm volatile("" : "+v"(lane_e));
#pragma unroll
        for (int i = 0; i < 8; ++i) { const int row = i * 4 + (lane_e >> 4), ch = lane_e & 15;
            const u32x4 v = *(const ATT_LAS u32x4*)(stg + row * 128 + ch * 8);
            const u32x4 g = *(const u32x4*)(G + (orow0 + row) * DM + h * 128 + ch * 8);
            const f32x4 sa = *(const f32x4*)(subln + ch * 8), sb = *(const f32x4*)(subln + ch * 8 + 4);
            const float sl[8] = {sa[0], sa[1], sa[2], sa[3], sb[0], sb[1], sb[2], sb[3]};
            u32x4 w;
#pragma unroll
            for (int e = 0; e < 4; ++e) { const float v0 = __uint_as_float(v[e] << 16), v1 = __uint_as_float(v[e] & 0xffff0000u), g0 = __uint_as_float(g[e] << 16), g1 = __uint_as_float(g[e] & 0xffff0000u);
                w[e] = cvtpk(v0 * sl[2 * e] * silu(g0), v1 * sl[2 * e + 1] * silu(g1)); }
            *(u32x4*)(O + (orow0 + row) * DM + h * 128 + ch * 8) = w; }
    }
    asm volatile("s_waitcnt vmcnt(0) lgkmcnt(0)\n\ts_barrier" ::: "memory");
    prof.epi += PRT() - pt2;
}
#undef ATT_STEP
#undef ATT_SB
#undef ATT_PIN
#undef ATT_WAIT_BAR
#undef ATT_MX3
}
constexpr int NWAVES = 8;
constexpr size_t MiB = 1u << 20;
constexpr size_t WS_CTL = 0, CTL_ZERO_BYTES = 1 * MiB;
constexpr size_t WS_WIN_A = 2 * MiB, WS_WOUT_A = 10 * MiB, WS_WCAT = 12 * MiB, WS_WOUT_B = 20 * MiB, WS_CS = 22 * MiB;
constexpr size_t WS_XN = 32 * MiB, WS_S0 = 96 * MiB, WS_S1 = 160 * MiB, WS_S2 = 224 * MiB, WS_S3 = 288 * MiB, WS_Y = 352 * MiB, WS_END = 480 * MiB;
constexpr size_t SPL = (size_t)T * DM;
constexpr int CW_TMO = 0, CW_CODE = 1, CW_BAR = 4096;
constexpr int N_BAR_REGIONS = 3;
constexpr int RING_OFF = 0, RING_BYTES = 151552;
constexpr int LDSCTL_OFF = RING_BYTES, MISC_OFF = LDSCTL_OFF + 320;
constexpr int LDS_BYTES = 155648;

#define GAS __attribute__((address_space(1)))
#define LAS __attribute__((address_space(3)))
typedef unsigned v4u __attribute__((ext_vector_type(4)));
typedef float f32x4 __attribute__((ext_vector_type(4)));
typedef short bf16x8 __attribute__((ext_vector_type(8)));
typedef GAS unsigned gu32;
#define RLX_AGENT __ATOMIC_RELAXED, __HIP_MEMORY_SCOPE_AGENT
#define LDS_WAIT() asm volatile("s_waitcnt lgkmcnt(0)" ::: "memory")
#define VM_WAIT() asm volatile("s_waitcnt vmcnt(0)" ::: "memory")
__device__ __forceinline__ unsigned pk2(float lo, float hi) { return (unsigned)f2bf(lo) | ((unsigned)f2bf(hi) << 16); }
__device__ __forceinline__ float wave_sum(float v) {
#pragma unroll
    for (int o = 1; o < 64; o <<= 1) v += __shfl_xor(v, o);
    return v;
}
#define XB_TMO      128
#define XB_XCNT(j)  (256  + 64 * (j))
#define XB_XSUB(j)  (1280 + 64 * (j))
#define XB_XGEN(j)  (2304 + 64 * (j))
#define XB_TOP      3328
#define XB_TOPGEN   3392
#define XCD_BAR_WORDS 3456
#define XB_SPIN_CAP (1u << 18)

__device__ __forceinline__ unsigned xb_ld(unsigned* p)              { return __hip_atomic_load(p, __ATOMIC_RELAXED, __HIP_MEMORY_SCOPE_AGENT); }
__device__ __forceinline__ unsigned xb_add(unsigned* p, unsigned v) { return __hip_atomic_fetch_add(p, v, __ATOMIC_RELAXED, __HIP_MEMORY_SCOPE_AGENT); }
__device__ __forceinline__ unsigned xb_xcc_id() { return (unsigned)__builtin_amdgcn_s_getreg((3 << 11) | 20) & 0xFu; }
#define XB_SPIN(cond, bar) do { unsigned _sp = 0; while (cond) { __builtin_amdgcn_s_sleep(1); \
    if ((++_sp & 255u) == 0u) { if (xb_ld(&(bar)[XB_TMO])) break; if (_sp > XB_SPIN_CAP) { atomicAdd(&(bar)[XB_TMO], 1u); break; } } } } while (0)

struct XcdBarrier {
    unsigned* bar; unsigned x;
    volatile LAS unsigned* st;
};

__device__ __forceinline__ XcdBarrier xcd_barrier_post(unsigned* bar, volatile LAS unsigned* st) {
    XcdBarrier b; b.bar = bar; b.x = xb_xcc_id(); b.st = st;
    if (threadIdx.x == 0) (void)xb_add(&bar[XB_XCNT(b.x)], 1u);
    return b;
}
__device__ __forceinline__ void xcd_barrier_complete(unsigned* bar, unsigned x, unsigned& nloc, unsigned& nx) {
    const unsigned G = gridDim.x * gridDim.y * gridDim.z;
    unsigned sum, cnt, mine, sp = 0u;
    for (;;) {
        sum = 0u; cnt = 0u; mine = 0u;
#pragma unroll
        for (unsigned j = 0; j < 16; ++j) { const unsigned c = xb_ld(&bar[XB_XCNT(j)]); sum += c; cnt += (c > 0u) ? 1u : 0u; mine = (j == x) ? c : mine; }
        if (sum == G) break;
        __builtin_amdgcn_s_sleep(1);
        if ((++sp & 255u) == 0u) { if (xb_ld(&bar[XB_TMO])) break; if (sp > XB_SPIN_CAP) { atomicAdd(&bar[XB_TMO], 1u); break; } }
    }
    nloc = mine > 0u ? mine : 1u; nx = cnt > 0u ? cnt : 1u;
}

__device__ __forceinline__ void xcd_barrier(const XcdBarrier& b) {
    asm volatile("s_waitcnt vmcnt(0)" ::: "memory");
    __syncthreads();
    if (threadIdx.x == 0) {
        unsigned* bar = b.bar;
        __builtin_amdgcn_s_waitcnt(0);
        unsigned nloc = b.st[0], nx = b.st[1];
        if (nloc == 0u) { xcd_barrier_complete(bar, b.x, nloc, nx); b.st[0] = nloc; b.st[1] = nx; }
        const unsigned old = xb_add(&bar[XB_XSUB(b.x)], 1u);
        const unsigned gen = old / nloc;
        if (old + 1u == (gen + 1u) * nloc) {
            __builtin_amdgcn_fence(__ATOMIC_RELEASE, "agent");
            asm volatile("s_waitcnt vmcnt(0)" ::: "memory");
            const unsigned og = xb_add(&bar[XB_TOP], 1u);
            const unsigned tg = og / nx;
            if (og + 1u == (tg + 1u) * nx) xb_add(&bar[XB_TOPGEN], 1u);
            else XB_SPIN(xb_ld(&bar[XB_TOPGEN]) == tg, bar);
            __builtin_amdgcn_fence(__ATOMIC_ACQUIRE, "agent");
            xb_add(&bar[XB_XGEN(b.x)], 1u);
            asm volatile("s_waitcnt vmcnt(0)" ::: "memory");
        } else {
            XB_SPIN(xb_ld(&bar[XB_XGEN(b.x)]) == gen, bar);
            __builtin_amdgcn_fence(__ATOMIC_ACQUIRE, "agent");
            asm volatile("s_waitcnt vmcnt(0)" ::: "memory");
        }
    }
    __syncthreads();
}
struct Frame {
    LAS unsigned char* lds;
    volatile LAS unsigned* MISC;
    gu32* ctl;
    int tid, lane, wave, vcu, G;
};

__device__ __forceinline__ void p0_transpose_item(const float* W, const float* g, int K, int N, bf16_t* WT, int row_off, LAS float* scr, int item, int lane) {
    const int nblk = N / 32, kb = item / nblk, nb = item % nblk, k0 = 64 * kb, n0 = 32 * nb;
#pragma unroll 8
    for (int i = 0; i < 32; ++i) { const int kk = 2 * i + (lane >> 5); const float gv = g ? g[k0 + kk] : 1.f; scr[kk * 33 + (lane & 31)] = W[(size_t)(k0 + kk) * N + n0 + (lane & 31)] * gv; }
    LDS_WAIT(); asm volatile("" ::: "memory");
    const int c = lane & 7;
#pragma unroll
    for (int j = 0; j < 4; ++j) { const int n = (lane >> 3) + 8 * j; const LAS float* s = scr + (8 * c) * 33 + n;
        v4u o; o.x = pk2(s[0 * 33], s[1 * 33]); o.y = pk2(s[2 * 33], s[3 * 33]); o.z = pk2(s[4 * 33], s[5 * 33]); o.w = pk2(s[6 * 33], s[7 * 33]);
        *(GAS v4u*)(WT + (size_t)(row_off + n0 + n) * K + k0 + 8 * c) = o; }
    LDS_WAIT(); asm volatile("" ::: "memory");
}
__device__ __forceinline__ void rms_row_to_bf16(int lane, const float* xrow, bf16_t* orow) {
    const GAS f32x4* xr = (const GAS f32x4*)xrow + lane;
    f32x4 v[4]; float s = 0.f;
#pragma unroll
    for (int j = 0; j < 4; ++j) { v[j] = xr[64 * j]; s += (v[j].x * v[j].x + v[j].y * v[j].y) + (v[j].z * v[j].z + v[j].w * v[j].w); }
    const float r = rsqrtf(wave_sum(s) * (1.f / DM) + EPS);
    GAS unsigned long long* o8 = (GAS unsigned long long*)orow + lane;
#pragma unroll
    for (int j = 0; j < 4; ++j) o8[64 * j] = (unsigned long long)pk2(v[j].x * r, v[j].y * r) | ((unsigned long long)pk2(v[j].z * r, v[j].w * r) << 32);
}
__device__ __forceinline__ void resnorm_row(int lane, const float* hin, const float* y, const float* g, float* hout, bf16_t* hn) {
    const GAS f32x4* yr = (const GAS f32x4*)y + lane; const GAS f32x4* hr = (const GAS f32x4*)hin + lane; const GAS f32x4* gr = (const GAS f32x4*)g + lane;
    f32x4 v[4], hv[4]; float s = 0.f;
#pragma unroll
    for (int j = 0; j < 4; ++j) { v[j] = yr[64 * j]; hv[j] = hr[64 * j]; s += (v[j].x * v[j].x + v[j].y * v[j].y) + (v[j].z * v[j].z + v[j].w * v[j].w); }
    const float r = rsqrtf(wave_sum(s) * (1.f / DM) + EPS);
    float s2 = 0.f;
    GAS f32x4* orow = (GAS f32x4*)hout + lane;
#pragma unroll
    for (int j = 0; j < 4; ++j) { v[j] = hv[j] + v[j] * r * gr[64 * j]; s2 += (v[j].x * v[j].x + v[j].y * v[j].y) + (v[j].z * v[j].z + v[j].w * v[j].w); orow[64 * j] = v[j]; }
    if (hn) {
        const float r2 = rsqrtf(wave_sum(s2) * (1.f / DM) + EPS);
        GAS unsigned long long* o8 = (GAS unsigned long long*)hn + lane;
#pragma unroll
        for (int j = 0; j < 4; ++j) o8[64 * j] = (unsigned long long)pk2(v[j].x * r2, v[j].y * r2) | ((unsigned long long)pk2(v[j].z * r2, v[j].w * r2) << 32);
    }
}

#if PROBE
#ifndef PROBE_WAVE
#define PROBE_WAVE 0
#endif
#ifndef PROBE_K
#define PROBE_K 2
#endif
#define PROBE_EMIT(ph, tot, pr) do { if (PROBE / 10 == (ph)) { const int q_ = PROBE % 10; \
    const unsigned long long v_ = q_ == 0 ? (tot) : q_ == 1 ? (pr).wait : q_ == 2 ? (pr).step : q_ == 3 ? (pr).pro : (pr).epi; \
    if (F.tid == PROBE_WAVE * 64) F.MISC[16] = (unsigned)v_; __syncthreads(); const unsigned long long w_ = (unsigned long long)F.MISC[16] * PROBE_K; \
    const unsigned long long t0_ = __builtin_amdgcn_s_memrealtime(); while (__builtin_amdgcn_s_memrealtime() - t0_ < w_) __builtin_amdgcn_s_sleep(8); __syncthreads(); } } while (0)
#else
#define PROBE_EMIT(ph, tot, pr) do { (void)(tot); } while (0)
#endif
struct Args { const float* in[18]; float* out; unsigned char* ws; int ph_lo, ph_hi, li, pad; };

__global__ void __launch_bounds__(NWAVES * 64, 2) mega_fwd(Args args) {
    extern __shared__ __attribute__((aligned(16))) unsigned char lds[];
    Frame F;
    F.lds = (LAS unsigned char*)lds;
    F.MISC = (volatile LAS unsigned*)(F.lds + MISC_OFF);
    F.tid = threadIdx.x; F.lane = F.tid & 63; F.wave = __builtin_amdgcn_readfirstlane(F.tid >> 6);
    F.G = gridDim.x; { const int bx = blockIdx.x; F.vcu = (F.G % 8 == 0) ? (bx % 8) * (F.G / 8) + bx / 8 : bx; }
    unsigned char* ws = args.ws;
    F.ctl = (gu32*)(ws + WS_CTL);
    const float* x = args.in[0]; const int* pos = (const int*)args.in[1];
    const float* a_norm_pre = args.in[2]; const float* a_w_in = args.in[3]; const float* a_rel_bias = args.in[4];
    const float* a_w_out = args.in[5]; const float* a_norm_post = args.in[6]; const float* kv_norm = args.in[7];
    const float* kv_w = args.in[8]; const float* b_norm_pre = args.in[9]; const float* b_w_in = args.in[10];
    const float* lq1 = args.in[11]; const float* lk1 = args.in[12]; const float* lq2 = args.in[13]; const float* lk2 = args.in[14];
    const float* b_subln = args.in[15]; const float* b_w_out = args.in[16]; const float* b_norm_post = args.in[17];
    float* out = args.out;
    bf16_t* Wt_in_a = (bf16_t*)(ws + WS_WIN_A); bf16_t* Wt_out_a = (bf16_t*)(ws + WS_WOUT_A); bf16_t* Wt_cat = (bf16_t*)(ws + WS_WCAT); bf16_t* Wt_out_b = (bf16_t*)(ws + WS_WOUT_B);
    float* cs = (float*)(ws + WS_CS);
    bf16_t* XN = (bf16_t*)(ws + WS_XN); bf16_t* S0 = (bf16_t*)(ws + WS_S0); bf16_t* S2 = (bf16_t*)(ws + WS_S2);
    float* Y = (float*)(ws + WS_Y);
    bf16_t* S1 = (bf16_t*)(ws + WS_S1); bf16_t* S3 = (bf16_t*)(ws + WS_S3);

    for (int u = F.tid; u < (LDS_BYTES - LDSCTL_OFF) / 4; u += NWAVES * 64) ((LAS unsigned*)(F.lds + LDSCTL_OFF))[u] = 0u;
    __syncthreads();
    XcdBarrier bar = xcd_barrier_post((unsigned*)(F.ctl + CW_BAR) + args.li * XCD_BAR_WORDS, F.MISC + 8);
    const int lo = args.ph_lo, hi = args.ph_hi;
#define IN(k) (lo <= (k) && (k) < hi)
#define BOTH(k) (IN(k) && IN((k) + 1))
    const int gw = F.vcu * NWAVES + F.wave, NGW = F.G * NWAVES;

    if (IN(0)) for (int rep_ = 0; rep_ < (DUP == 0 ? 2 : 1); ++rep_) {
        LAS float* scr = (LAS float*)(F.lds + RING_OFF + F.wave * 16384);
        constexpr int I_IN = 16 * 128, I_OUT = 16 * 32, I_KV = 16 * 64;
        constexpr int NITEMS = I_IN + I_OUT + 2 * I_KV + I_OUT;
        for (int it = gw; it < NITEMS; it += NGW) {
            int r = it;
            if (r < I_IN) { p0_transpose_item(a_w_in, a_norm_pre, 1024, 4096, Wt_in_a, 0, scr, r, F.lane); continue; } r -= I_IN;
            if (r < I_OUT) { p0_transpose_item(a_w_out, nullptr, 1024, 1024, Wt_out_a, 0, scr, r, F.lane); continue; } r -= I_OUT;
            if (r < I_KV) { p0_transpose_item(kv_w, kv_norm, 1024, 2048, Wt_cat, 0, scr, r, F.lane); continue; } r -= I_KV;
            if (r < I_KV) { p0_transpose_item(b_w_in, b_norm_pre, 1024, 2048, Wt_cat, 2048, scr, r, F.lane); continue; } r -= I_KV;
            p0_transpose_item(b_w_out, nullptr, 1024, 1024, Wt_out_b, 0, scr, r, F.lane);
        }
        for (int m = gw; m < T; m += NGW) rms_row_to_bf16(F.lane, x + (size_t)m * DM, XN + (size_t)m * DM);
        for (int idx = blockIdx.x * 512 + F.tid; idx < T * 8; idx += F.G * 512) {
            const int t = idx >> 3, i = idx & 7;
            const float inv = powf(500000.0f, -(float)i * 0.125f);
            const float ang = (float)pos[t] * inv;
            cs[t * 16 + i] = cosf(ang); cs[t * 16 + 8 + i] = sinf(ang);
        }
    }
    if (BOTH(0)) xcd_barrier(bar);
    if (IN(1)) for (int rep_ = 0; rep_ < (DUP == 1 ? 2 : 1); ++rep_) {
        pg8::Gemm g{XN, Wt_in_a, T, 4096, 1024}; pg8::StaticOrder S; S.init(T, 4096, F.G, (int)blockIdx.x);
        pg8::EpiSplit E{S0, SPL, 0, C2, 0u, cs};
        pg8::gemm_phase<pg8::EpiSplit, pg8::StaticOrder, true, true>(F.lds + RING_OFF, g, S, E);
    }
    if (BOTH(1)) xcd_barrier(bar);
    if (IN(2)) for (int rep_ = 0; rep_ < (DUP == 2 ? 2 : 1); ++rep_) {
        bf16_t* OGA = (DUP == 2 && rep_ == 0) ? XN : S0;
        att::Prof prof{0ull, 0ull, 0ull, 0ull}; const unsigned long long ph0 = PRT();
        for (int bh = F.vcu; bh < BATCH * 16; bh += F.G)
            for (int u = 0; u < 8; ++u) att::attn_a_unit(bh >> 4, bh & 15, u, S0, S1, S2, S3, OGA, pos, a_rel_bias, (att::lds_u8*)(F.lds + RING_OFF), prof);
        PROBE_EMIT(1, PRT() - ph0, prof);
    }
    if (BOTH(2)) xcd_barrier(bar);
    if (IN(3)) for (int rep_ = 0; rep_ < (DUP == 3 ? 2 : 1); ++rep_) {
        pg8::Gemm g{S0, Wt_out_a, T, 1024, 1024}; pg8::StaticOrder S; S.init(T, 1024, F.G, (int)blockIdx.x);
        pg8::EpiF32 E{Y, 1024};
        pg8::gemm_phase<pg8::EpiF32, pg8::StaticOrder, true, true>(F.lds + RING_OFF, g, S, E);
    }
    if (BOTH(3)) xcd_barrier(bar);
    if (IN(4)) for (int rep_ = 0; rep_ < (DUP == 4 ? 2 : 1); ++rep_) {
        for (int m = gw; m < T; m += NGW) resnorm_row(F.lane, x + (size_t)m * DM, Y + (size_t)m * DM, a_norm_post, out + (size_t)m * DM, XN + (size_t)m * DM);
    }
    if (BOTH(4)) xcd_barrier(bar);
    if (IN(5)) for (int rep_ = 0; rep_ < (DUP == 5 ? 2 : 1); ++rep_) {
        pg8::Gemm g{XN, Wt_cat, T, 4096, 1024}; pg8::StaticOrder S; S.init(T, 4096, F.G, (int)blockIdx.x);
        pg8::EpiSplit E{S0, SPL, 2, C2, 0x5u, cs};
        pg8::gemm_phase<pg8::EpiSplit, pg8::StaticOrder, true, true>(F.lds + RING_OFF, g, S, E);
    }
    if (BOTH(5)) xcd_barrier(bar);
    if (IN(6)) for (int rep_ = 0; rep_ < (DUP == 6 ? 2 : 1); ++rep_) {
        bf16_t* OGB = (DUP == 6 && rep_ == 0) ? (bf16_t*)Y : S2;
        att::Prof prof{0ull, 0ull, 0ull, 0ull}; const unsigned long long ph0 = PRT();
        float lam; { float a = lq1[F.lane] * lk1[F.lane], c = lq2[F.lane] * lk2[F.lane]; a = wave_sum(a); c = wave_sum(c); lam = __expf(a) - __expf(c) + LAM_INIT; }
        for (int v = F.vcu; v < 256; v += F.G) { const int xcd = v >> 5, c = v & 31, k = c & 7;
            for (int r = 0; r < 4; ++r) { const int bh = 16 * xcd + 4 * r + (c >> 3);
                for (int j = 0; j < 2; ++j) { const int qb = j ? 15 - k : k;
                    att::attn_b_unit(bh >> 3, bh & 7, qb, S2, S0, S1, S3, OGB, b_subln, lam, (att::lds_u8*)(F.lds + RING_OFF), prof); } } }
        PROBE_EMIT(2, PRT() - ph0, prof);
    }
    if (BOTH(6)) xcd_barrier(bar);
    if (IN(7)) for (int rep_ = 0; rep_ < (DUP == 7 ? 2 : 1); ++rep_) {
        pg8::Gemm g{S2, Wt_out_b, T, 1024, 1024}; pg8::StaticOrder S; S.init(T, 1024, F.G, (int)blockIdx.x);
        pg8::EpiF32 E{Y, 1024};
        pg8::gemm_phase<pg8::EpiF32, pg8::StaticOrder, true, true>(F.lds + RING_OFF, g, S, E);
    }
    if (BOTH(7)) xcd_barrier(bar);
    if (IN(8)) for (int rep_ = 0; rep_ < (DUP == 8 ? 2 : 1); ++rep_) {
        float* OUT8 = (DUP == 8 && rep_ == 0) ? (float*)S0 : out;
        for (int m = gw; m < T; m += NGW) resnorm_row(F.lane, out + (size_t)m * DM, Y + (size_t)m * DM, b_norm_post, OUT8 + (size_t)m * DM, nullptr);
    }
#undef IN
#undef BOTH
}

extern "C" void kernel_launch(void* const* d_in, const int* in_sizes, int n_in, void* d_out, int out_size, void* d_ws, size_t ws_size, hipStream_t stream) {
    static int grid = 0;
    if (grid == 0) {
        if (n_in != 18 || out_size != T * DM || ws_size < WS_END) { fprintf(stderr, "kernel_launch: unexpected shapes (n_in %d out %d ws %zu)\n", n_in, out_size, ws_size); grid = -1; return; }
        int dev = 0, cus = 0;
        if (hipGetDevice(&dev) != hipSuccess || hipDeviceGetAttribute(&cus, hipDeviceAttributeMultiprocessorCount, dev) != hipSuccess) { grid = -1; return; }
        if (hipFuncSetAttribute((const void*)mega_fwd, hipFuncAttributeMaxDynamicSharedMemorySize, LDS_BYTES) != hipSuccess) { fprintf(stderr, "kernel_launch: hipFuncSetAttribute failed\n"); grid = -1; return; }
        grid = cus;
    }
    if (grid < 0) return;
    (void)hipMemsetAsync((char*)d_ws + WS_CTL, 0, CTL_ZERO_BYTES, stream);
    Args a{};
    for (int i = 0; i < 18; ++i) a.in[i] = (const float*)d_in[i];
    a.out = (float*)d_out; a.ws = (unsigned char*)d_ws;
    unsigned char* ws = (unsigned char*)d_ws; (void)ws;
    int lo = 0, li = 0;
#define MEGA(l_, h_) do { a.ph_lo = (l_); a.ph_hi = (h_); a.li = li++; hipLaunchKernelGGL(mega_fwd, dim3(grid), dim3(NWAVES * 64), LDS_BYTES, stream, a); } while (0)
#if HYBRID & 1
    { bf16_t* S0 = (bf16_t*)(ws + WS_S0); bf16_t* S1 = (bf16_t*)(ws + WS_S1); bf16_t* S2 = (bf16_t*)(ws + WS_S2); bf16_t* S3 = (bf16_t*)(ws + WS_S3);
      MEGA(lo, 2); attn_a_naive<<<T * 16 / 64, 64, 0, stream>>>(S0, S1, S2, S3, (const int*)d_in[1], (const float*)d_in[4], S0); lo = 3; }
#endif
#if HYBRID & 2
    { bf16_t* S0 = (bf16_t*)(ws + WS_S0); bf16_t* S1 = (bf16_t*)(ws + WS_S1); bf16_t* S2 = (bf16_t*)(ws + WS_S2); bf16_t* S3 = (bf16_t*)(ws + WS_S3);
      MEGA(lo, 6); attn_b_naive<<<T * 8 * 2 / 64, 64, 0, stream>>>(S2, S0, S1, S3, (const float*)d_in[11], (const float*)d_in[12], (const float*)d_in[13], (const float*)d_in[14], (const float*)d_in[15], S2); lo = 7; }
#endif
    MEGA(lo, 9);
#undef MEGA
}
```
